# Optimizing an MI355X kernel written in HIP

```python
import math
import jax, jax.numpy as jnp
from jax import lax
import numpy as np

D_MODEL = 1024
BATCH = 4
SEQ = 8192
DEPTH = 2

MEM_LEN = 256
MIX_W = D_MODEL
GROUP_W = MIX_W // 4
N_FOX_HEADS = 4
N_SB_HEADS = 4
N_MLA_HEADS = 4
N_MEM_HEADS = 4
HEAD_DIM = GROUP_W // 4
MLA_Q_RANK = 256
MLA_KV_RANK = 128
MLA_NOPE = HEAD_DIM
MLA_ROPE = 32
MLA_V = GROUP_W // N_MLA_HEADS
ROPE_THETA = 10000.0
BLOCK_Q = 128
LN_EPS = 1e-5
RMS_EPS = 1e-6
FOX_FORGET_BIAS_INIT = 3.0
DEEPNORM_ALPHA = (2 * DEPTH) ** 0.25
DEEPNORM_BETA = (8 * DEPTH) ** -0.25
SPLIT_SIZES = (GROUP_W, GROUP_W, GROUP_W, N_FOX_HEADS,
               GROUP_W, GROUP_W, GROUP_W,
               MLA_Q_RANK, MLA_KV_RANK, MLA_ROPE,
               GROUP_W,
               MIX_W)
IN_COLS = sum(SPLIT_SIZES)

kernel_name = 'hybrid_fox_stickbreak_mla_memory_deepnorm'


def _layer_norm(x, g, b):
    xf = x.astype(jnp.float32)
    mu = jnp.mean(xf, axis=-1, keepdims=True)
    var = jnp.mean(jnp.square(xf - mu), axis=-1, keepdims=True)
    y = (xf - mu) * lax.rsqrt(var + LN_EPS) * g.astype(jnp.float32) + b.astype(jnp.float32)
    return y.astype(x.dtype)


def _rms_norm(x, g):
    xf = x.astype(jnp.float32)
    y = xf * lax.rsqrt(jnp.mean(jnp.square(xf), axis=-1, keepdims=True) + RMS_EPS)
    return (y * g.astype(jnp.float32)).astype(x.dtype)


def _heads(t, n):
    b, s, _ = t.shape
    return t.reshape(b, s, n, -1).transpose(0, 2, 1, 3)


def _merge(t):
    b, h, s, d = t.shape
    return t.transpose(0, 2, 1, 3).reshape(b, s, h * d)


def _rope(x, positions):
    half = x.shape[-1] // 2
    inv_freq = ROPE_THETA ** (-jnp.arange(half, dtype=jnp.float32) / half)
    ang = positions.astype(jnp.float32)[:, None] * inv_freq[None, :]
    ang = ang.reshape((ang.shape[0],) + (1,) * (x.ndim - 3) + (half,))
    cos, sin = jnp.cos(ang), jnp.sin(ang)
    xf = x.astype(jnp.float32)
    x1, x2 = xf[..., :half], xf[..., half:]
    return jnp.concatenate([x1 * cos - x2 * sin, x1 * sin + x2 * cos], axis=-1).astype(x.dtype)


def _sweep_query_blocks(block_fn, per_query):
    b, h, s = per_query[0].shape[:3]
    nb = s // BLOCK_Q
    blocks = tuple(jnp.moveaxis(a.reshape((b, h, nb, BLOCK_Q) + a.shape[3:]), 2, 0) for a in per_query)
    out = lax.map(lambda args: block_fn(args[0], *args[1:]), (jnp.arange(nb),) + blocks)
    out = jnp.moveaxis(out, 0, 2)
    return out.reshape(b, h, s, out.shape[-1])


def _causal_softmax_attention(q, k, v, scale, log_forget_cum=None):
    key_pos = jnp.arange(k.shape[2])

    def block(i, qb, *fq):
        q_pos = i * BLOCK_Q + jnp.arange(BLOCK_Q)
        logits = jnp.einsum('bhqd,bhkd->bhqk', qb, k).astype(jnp.float32) * scale
        if log_forget_cum is not None:
            logits = logits + fq[0][..., :, None] - log_forget_cum[:, :, None, :]
        mask = key_pos[None, :] <= q_pos[:, None]
        probs = jax.nn.softmax(jnp.where(mask, logits, -jnp.inf), axis=-1)
        return jnp.einsum('bhqk,bhkd->bhqd', probs.astype(v.dtype), v)

    per_query = (q,) if log_forget_cum is None else (q, log_forget_cum)
    return _sweep_query_blocks(block, per_query)


def _stick_breaking_attention(q, k, v, scale):
    key_pos = jnp.arange(k.shape[2])

    def block(i, qb):
        q_pos = i * BLOCK_Q + jnp.arange(BLOCK_Q)
        valid = key_pos[None, :] < q_pos[:, None]
        z = jnp.einsum('bhqd,bhkd->bhqk', qb, k).astype(jnp.float32) * scale
        log_keep = jnp.where(valid, jax.nn.log_sigmoid(-z), 0.0)
        log_tail = lax.cumsum(log_keep, axis=3, reverse=True) - log_keep
        w = jnp.where(valid, jnp.exp(jax.nn.log_sigmoid(z) + log_tail), 0.0)
        return jnp.einsum('bhqk,bhkd->bhqd', w.astype(v.dtype), v)

    return _sweep_query_blocks(block, (q,))


def setup_inputs(seed: int = 0) -> dict:
    key = jax.random.key(seed)
    ks = jax.random.split(key, 18)
    f32 = jnp.float32
    nrm = lambda k, shape: jax.random.normal(k, shape, f32)
    return {
        'x': nrm(ks[0], (BATCH, SEQ, D_MODEL)),
        'mem': nrm(ks[1], (BATCH, MEM_LEN, D_MODEL)),
        'ln_in_g': 1.0 + 0.02 * nrm(ks[2], (D_MODEL,)),
        'ln_in_b': 0.02 * nrm(ks[3], (D_MODEL,)),
        'mem_ln_g': 1.0 + 0.02 * nrm(ks[4], (D_MODEL,)),
        'mem_ln_b': 0.02 * nrm(ks[5], (D_MODEL,)),
        'w_in': nrm(ks[6], (DEPTH, D_MODEL, IN_COLS)) * D_MODEL ** -0.5,
        'b_forget': FOX_FORGET_BIAS_INIT + 0.1 * nrm(ks[7], (DEPTH, N_FOX_HEADS)),
        'mla_q_norm_g': 1.0 + 0.02 * nrm(ks[8], (DEPTH, MLA_Q_RANK)),
        'w_mla_q_up': nrm(ks[9], (DEPTH, MLA_Q_RANK, N_MLA_HEADS * (MLA_NOPE + MLA_ROPE))) * MLA_Q_RANK ** -0.5,
        'mla_kv_norm_g': 1.0 + 0.02 * nrm(ks[10], (DEPTH, MLA_KV_RANK)),
        'w_mla_kv_up': nrm(ks[11], (DEPTH, MLA_KV_RANK, N_MLA_HEADS * (MLA_NOPE + MLA_V))) * MLA_KV_RANK ** -0.5,
        'w_mem_kv': nrm(ks[12], (DEPTH, D_MODEL, 2 * GROUP_W)) * D_MODEL ** -0.5,
        'w_out': nrm(ks[13], (DEPTH, MIX_W, D_MODEL)) * (MIX_W ** -0.5 * DEEPNORM_BETA),
        'ln_g': 1.0 + 0.02 * nrm(ks[14], (DEPTH, D_MODEL)),
        'ln_b': 0.02 * nrm(ks[15], (DEPTH, D_MODEL)),
    }


def reference(x, mem, ln_in_g, ln_in_b, mem_ln_g, mem_ln_b, w_in, b_forget,
              mla_q_norm_g, w_mla_q_up, mla_kv_norm_g, w_mla_kv_up, w_mem_kv,
              w_out, ln_g, ln_b):
    b, s, _ = x.shape
    positions = jnp.arange(s)
    offsets = [int(o) for o in np.cumsum(SPLIT_SIZES)[:-1]]
    head_scale = HEAD_DIM ** -0.5
    mla_scale = (MLA_NOPE + MLA_ROPE) ** -0.5

    h_res = _layer_norm(x, ln_in_g, ln_in_b)
    mem_n = _layer_norm(mem, mem_ln_g, mem_ln_b)

    for l in range(DEPTH):
        proj = jnp.einsum('bsd,dc->bsc', h_res, w_in[l])
        (fq, fk, fv, f_logit, sq, sk, sv, c_q, c_kv, k_rot, mq, gate) = jnp.split(proj, offsets, axis=-1)

        log_f = jax.nn.log_sigmoid((f_logit + b_forget[l]).astype(jnp.float32))
        f_cum = jnp.cumsum(log_f, axis=1).transpose(0, 2, 1)
        out_fox = _causal_softmax_attention(_heads(fq, N_FOX_HEADS), _heads(fk, N_FOX_HEADS),
                                            _heads(fv, N_FOX_HEADS), head_scale, f_cum)

        out_sb = _stick_breaking_attention(_heads(sq, N_SB_HEADS), _heads(sk, N_SB_HEADS),
                                           _heads(sv, N_SB_HEADS), head_scale)

        q_mla = jnp.einsum('bsr,rc->bsc', _rms_norm(c_q, mla_q_norm_g[l]), w_mla_q_up[l])
        q_mla = q_mla.reshape(b, s, N_MLA_HEADS, MLA_NOPE + MLA_ROPE)
        q_full = jnp.concatenate([q_mla[..., :MLA_NOPE], _rope(q_mla[..., MLA_NOPE:], positions)], axis=-1)
        kv_mla = jnp.einsum('bsr,rc->bsc', _rms_norm(c_kv, mla_kv_norm_g[l]), w_mla_kv_up[l])
        kv_mla = kv_mla.reshape(b, s, N_MLA_HEADS, MLA_NOPE + MLA_V)
        k_rope = jnp.broadcast_to(_rope(k_rot, positions)[:, :, None, :], (b, s, N_MLA_HEADS, MLA_ROPE))
        k_full = jnp.concatenate([kv_mla[..., :MLA_NOPE], k_rope], axis=-1)
        v_mla = kv_mla[..., MLA_NOPE:]
        out_mla = _causal_softmax_attention(q_full.transpose(0, 2, 1, 3), k_full.transpose(0, 2, 1, 3),
                                            v_mla.transpose(0, 2, 1, 3), mla_scale)

        mkv = jnp.einsum('bmd,dc->bmc', mem_n, w_mem_kv[l])
        mk, mv = _heads(mkv[..., :GROUP_W], N_MEM_HEADS), _heads(mkv[..., GROUP_W:], N_MEM_HEADS)
        mem_logits = jnp.einsum('bhsd,bhmd->bhsm', _heads(mq, N_MEM_HEADS), mk).astype(jnp.float32) * head_scale
        mem_p = jax.nn.softmax(mem_logits, axis=-1)
        out_mem = jnp.einsum('bhsm,bhmd->bhsd', mem_p.astype(mv.dtype), mv)

        mixed = jnp.concatenate([_merge(out_fox), _merge(out_sb), _merge(out_mla), _merge(out_mem)], axis=-1)
        y = jnp.einsum('bsc,cd->bsd', mixed * jax.nn.silu(gate), w_out[l])

        h_res = _layer_norm(DEEPNORM_ALPHA * h_res + y, ln_g[l], ln_b[l])

    return h_res
```

```cpp
#include <hip/hip_runtime.h>
#include <hip/hip_cooperative_groups.h>
#include <cstdio>
#include <cstdint>
namespace cg = cooperative_groups;

typedef unsigned short bf16_t;
typedef short bf16x8 __attribute__((ext_vector_type(8)));
typedef float f32x16 __attribute__((ext_vector_type(16)));
typedef float f32x4 __attribute__((ext_vector_type(4)));
typedef float f32x2 __attribute__((ext_vector_type(2)));
typedef __bf16 bf16v2 __attribute__((ext_vector_type(2)));
typedef unsigned u32x4 __attribute__((ext_vector_type(4)));
typedef unsigned u32x2 __attribute__((ext_vector_type(2)));

#define DI __device__ __forceinline__
#define XCD_BAR_WORDS 3456
#define MFMA(a, b, c) __builtin_amdgcn_mfma_f32_32x32x16_bf16((a), (b), (c), 0, 0, 0)

constexpr int B_ = 4, S_ = 8192, T_ = B_ * S_, D_ = 1024, NP_ = 3328, MEM_ = 256, INC_ = 3236;
constexpr float LOG2E = 1.4426950408889634f;
constexpr float QSCALE = 0.125f * LOG2E;
constexpr float MLASCALE = 0.10206207261596575f * LOG2E;
constexpr float ALPHA = 1.4142135623730951f;
constexpr int LDT = 72;
constexpr int SMEM_GEMM = 2 * 2 * 128 * LDT * 2;
constexpr int SMEM_BYTES = SMEM_GEMM + 1024;

struct Params {
  const float *x, *mem, *ln_in_g, *ln_in_b, *mem_ln_g, *mem_ln_b, *w_in, *b_forget, *q_norm_g, *w_q_up, *kv_norm_g, *w_kv_up, *w_mem_kv, *w_out, *ln_g, *ln_b;
  float* hres;
  bf16_t *hb, *mixedg, *gs, *memn;
  bf16_t *WinT, *WmemT, *WqupT, *WkvupT, *WoutT;
  bf16_t *Qf, *Kf, *Vtf, *Qs, *Ks, *Vts, *Qm, *Km, *Vtm, *Qx, *Kx, *Vtx;
  bf16_t *cq, *ckv, *krope;
  float *logf, *Fc, *knorm;
  float2* ropetab;
  unsigned* counters;
  unsigned* xbar;
  float2 *stat0, *stat1;
};

typedef const Params __attribute__((address_space(4)))* PP;
DI PP launder(PP p) { asm volatile("" : "+s"(p)); return p; }
DI int get_tid() { int t = threadIdx.x; asm volatile("" : "+v"(t)); return t; }
DI unsigned pack2(float a, float b) { f32x2 v = {a, b}; return __builtin_bit_cast(unsigned, __builtin_convertvector(v, bf16v2)); }
DI u32x2 pack4(float a, float b, float c, float d) { u32x2 r; r.x = pack2(a, b); r.y = pack2(c, d); return r; }
DI float bf2f(unsigned short x) { return __uint_as_float(((unsigned)x) << 16); }
DI float wave_sum(float v) {
#pragma unroll
  for (int o = 32; o >= 1; o >>= 1) v += __shfl_xor(v, o);
  return v;
}

DI void ln_row_wave(const float* src, float* dstf, bf16_t* dstb, const float* g, const float* bb, int lane) {
  f32x4 v[4];
#pragma unroll
  for (int i = 0; i < 4; ++i) v[i] = *(const f32x4*)(src + (i * 64 + lane) * 4);
  float s = 0.f;
#pragma unroll
  for (int i = 0; i < 4; ++i) s += v[i].x + v[i].y + v[i].z + v[i].w;
  s = wave_sum(s);
  const float mu = s * (1.f / 1024.f);
  float q = 0.f;
#pragma unroll
  for (int i = 0; i < 4; ++i) { f32x4 d = v[i] - mu; q += d.x * d.x + d.y * d.y + d.z * d.z + d.w * d.w; }
  q = wave_sum(q);
  const float rstd = rsqrtf(q * (1.f / 1024.f) + 1e-5f);
#pragma unroll
  for (int i = 0; i < 4; ++i) {
    const int c = (i * 64 + lane) * 4;
    f32x4 gg = *(const f32x4*)(g + c), b4 = *(const f32x4*)(bb + c);
    f32x4 y = (v[i] - mu) * rstd * gg + b4;
    if (dstf) *(f32x4*)(dstf + c) = y;
    if (dstb) *(u32x2*)(dstb + c) = pack4(y.x, y.y, y.z, y.w);
  }
}

template <int NR, bool NTL = false, bool NTS = false>
DI void ln_rows_wave(const float* src, float* dstf, bf16_t* dstb, float2* stats, const f32x4 (&gg)[4], const f32x4 (&bb)[4], int lane) {
  f32x4 v[NR][4];
#pragma unroll
  for (int r = 0; r < NR; ++r)
#pragma unroll
    for (int i = 0; i < 4; ++i) { const f32x4* sp = (const f32x4*)(src + (size_t)r * 1024 + (i * 64 + lane) * 4); v[r][i] = NTL ? __builtin_nontemporal_load(sp) : *sp; }
  float s[NR];
#pragma unroll
  for (int r = 0; r < NR; ++r) {
    s[r] = 0.f;
#pragma unroll
    for (int i = 0; i < 4; ++i) s[r] += v[r][i].x + v[r][i].y + v[r][i].z + v[r][i].w;
  }
#pragma unroll
  for (int o = 32; o >= 1; o >>= 1)
#pragma unroll
    for (int r = 0; r < NR; ++r) s[r] += __shfl_xor(s[r], o);
  float q[NR];
#pragma unroll
  for (int r = 0; r < NR; ++r) {
    const float mu = s[r] * (1.f / 1024.f);
    s[r] = mu; q[r] = 0.f;
#pragma unroll
    for (int i = 0; i < 4; ++i) { v[r][i] = v[r][i] - mu; q[r] += v[r][i].x * v[r][i].x + v[r][i].y * v[r][i].y + v[r][i].z * v[r][i].z + v[r][i].w * v[r][i].w; }
  }
#pragma unroll
  for (int o = 32; o >= 1; o >>= 1)
#pragma unroll
    for (int r = 0; r < NR; ++r) q[r] += __shfl_xor(q[r], o);
#pragma unroll
  for (int r = 0; r < NR; ++r) {
    const float rstd = rsqrtf(q[r] * (1.f / 1024.f) + 1e-5f);
    if (stats && lane == 0) { float2 st; st.x = s[r]; st.y = rstd; stats[r] = st; }
#pragma unroll
    for (int i = 0; i < 4; ++i) {
      const int c = (i * 64 + lane) * 4;
      const f32x4 y = v[r][i] * rstd * gg[i] + bb[i];
      if (dstf) { f32x4* dp = (f32x4*)(dstf + (size_t)r * 1024 + c); if (NTS) __builtin_nontemporal_store(y, dp); else *dp = y; }
      if (dstb) *(u32x2*)(dstb + (size_t)r * 1024 + c) = pack4(y.x, y.y, y.z, y.w);
    }
  }
}

DI int map_win(int n) {
  if (n < 768) return n;
  if (n < 1536) return n + 4;
  if (n < 1792) return n + 4;
  if (n < 1920) return n + 4;
  if (n < 2048) {
    const int j = n - 1920;
    if (j < 16) return 1924 + j;
    if (j < 20) return 768 + (j - 16);
    if (j < 32) return -1;
    if (j < 48) return 1924 + 16 + (j - 32);
    return -1;
  }
  if (n < 2304) return 1956 + (n - 2048);
  return 2212 + (n - 2304);
}
DI int map_qup(int n) {
  if (n < 256) return (n >> 6) * 96 + (n & 63);
  const int j = n - 256, blk = j >> 5, c = j & 31;
  const int head = (blk >> 1) * 2 + (c >> 4), isx2 = blk & 1, i = c & 15;
  return head * 96 + 64 + isx2 * 16 + i;
}
DI int map_kvup(int n) {
  if (n < 256) return (n >> 6) * 128 + (n & 63);
  const int m = n - 256;
  return (m >> 6) * 128 + 64 + (m & 63);
}

DI void wconv_tile(const float* __restrict__ src, int ldsrc, const float* __restrict__ rowscale, bf16_t* __restrict__ dst, int K, int k0, int n0, int kind, float* tile) {
  const int tid = get_tid();
  {
    const int c = tid & 63, kr = tid >> 6;
    const int n = n0 + c;
    const int col = kind == 0 ? map_win(n) : kind == 1 ? map_qup(n) : kind == 2 ? map_kvup(n) : n;
#pragma unroll 4
    for (int i = 0; i < 16; ++i) {
      const int k = kr + 4 * i;
      float v = 0.f;
      if (col >= 0) v = src[(size_t)(k0 + k) * ldsrc + col];
      if (rowscale) v *= rowscale[k0 + k];
      tile[k * 65 + c] = v;
    }
  }
  __syncthreads();
  {
    const int n = tid >> 2, kc = (tid & 3) * 16;
    float v[16];
#pragma unroll
    for (int e = 0; e < 16; ++e) v[e] = tile[(kc + e) * 65 + n];
    u32x4 a, b;
    a.x = pack2(v[0], v[1]); a.y = pack2(v[2], v[3]); a.z = pack2(v[4], v[5]); a.w = pack2(v[6], v[7]);
    b.x = pack2(v[8], v[9]); b.y = pack2(v[10], v[11]); b.z = pack2(v[12], v[13]); b.w = pack2(v[14], v[15]);
    bf16_t* d = dst + (size_t)(n0 + n) * K + k0 + kc;
    *(u32x4*)d = a; *(u32x4*)(d + 8) = b;
  }
  __syncthreads();
}

DI void phase0(PP p, char* smem) {
  const int tid = get_tid(), lane = tid & 63, wave = tid >> 6;
  if (blockIdx.x == 0 && tid < 8) p->counters[tid] = 0u;
  constexpr int J_LNX = 1024, J_LNM = 32, J_ROPE = 512, J_WIN = 2 * 16 * 52, J_WMEM = 2 * 16 * 8, J_QUP = 2 * 4 * 6, J_KVUP = 2 * 2 * 8, J_WOUT = 2 * 16 * 16;
  constexpr int NJ = J_LNX + J_LNM + J_ROPE + J_WIN + J_WMEM + J_QUP + J_KVUP + J_WOUT;
  float* tile = (float*)smem;
  for (int job = blockIdx.x; job < NJ; job += gridDim.x) {
    int j = job;
    if (j < J_LNX) {
      f32x4 gg[4], bb[4];
#pragma unroll
      for (int i = 0; i < 4; ++i) { gg[i] = *(const f32x4*)(p->ln_in_g + (i * 64 + lane) * 4); bb[i] = *(const f32x4*)(p->ln_in_b + (i * 64 + lane) * 4); }
      for (int r = 0; r < 8; r += 4) {
        const size_t row = (size_t)j * 32 + wave * 8 + r;
        ln_rows_wave<4, true, false>(p->x + row * 1024, nullptr, p->hb + row * 1024, p->stat0 + row, gg, bb, lane);
      }
      continue;
    }
    j -= J_LNX;
    if (j < J_LNM) {
      f32x4 gg[4], bb[4];
#pragma unroll
      for (int i = 0; i < 4; ++i) { gg[i] = *(const f32x4*)(p->mem_ln_g + (i * 64 + lane) * 4); bb[i] = *(const f32x4*)(p->mem_ln_b + (i * 64 + lane) * 4); }
      for (int r = 0; r < 8; r += 4) {
        const size_t row = (size_t)j * 32 + wave * 8 + r;
        ln_rows_wave<4, true, false>(p->mem + row * 1024, nullptr, p->memn + row * 1024, nullptr, gg, bb, lane);
      }
      continue;
    }
    j -= J_LNM;
    if (j < J_ROPE) {
      const int e = j * 256 + tid;
      const int s = e >> 4, i = e & 15;
      const float inv = exp2f(-(float)i * (13.287712379549449f / 16.f));
      const float ang = (float)s * inv;
      double rev = (double)ang * 0.15915494309189535;
      rev = rev - floor(rev);
      const float fr = (float)rev;
      float2 cs; cs.x = __builtin_amdgcn_cosf(fr); cs.y = __builtin_amdgcn_sinf(fr);
      p->ropetab[e] = cs;
      continue;
    }
    j -= J_ROPE;
    if (j < J_WIN) {
      const int l = j / 832, r = j % 832, kt = r / 52, nt = r % 52;
      wconv_tile(p->w_in + (size_t)l * 1024 * INC_, INC_, nullptr, p->WinT + (size_t)l * NP_ * 1024, 1024, kt * 64, nt * 64, 0, tile);
      continue;
    }
    j -= J_WIN;
    if (j < J_WMEM) {
      const int l = j / 128, r = j % 128, kt = r / 8, nt = r % 8;
      wconv_tile(p->w_mem_kv + (size_t)l * 1024 * 512, 512, nullptr, p->WmemT + (size_t)l * 512 * 1024, 1024, kt * 64, nt * 64, 3, tile);
      continue;
    }
    j -= J_WMEM;
    if (j < J_QUP) {
      const int l = j / 24, r = j % 24, kt = r / 6, nt = r % 6;
      wconv_tile(p->w_q_up + (size_t)l * 256 * 384, 384, p->q_norm_g + l * 256, p->WqupT + (size_t)l * 384 * 256, 256, kt * 64, nt * 64, 1, tile);
      continue;
    }
    j -= J_QUP;
    if (j < J_KVUP) {
      const int l = j / 16, r = j % 16, kt = r / 8, nt = r % 8;
      wconv_tile(p->w_kv_up + (size_t)l * 128 * 512, 512, p->kv_norm_g + l * 128, p->WkvupT + (size_t)l * 512 * 128, 128, kt * 64, nt * 64, 2, tile);
      continue;
    }
    j -= J_KVUP;
    {
      const int l = j / 256, r = j % 256, kt = r / 16, nt = r % 16;
      wconv_tile(p->w_out + (size_t)l * 1024 * 1024, 1024, nullptr, p->WoutT + (size_t)l * 1024 * 1024, 1024, kt * 64, nt * 64, 3, tile);
    }
  }
}

template <bool SWAP>
DI void gemm_block(const bf16_t* __restrict__ A, int lda, const bf16_t* __restrict__ Bt, int ldb, int K, f32x16 (&acc)[2][2], bf16_t* sA, bf16_t* sB) {
  const int tid = get_tid(), lane = tid & 63, wave = tid >> 6, wr = wave >> 1, wc = wave & 1, l32 = lane & 31, h = lane >> 5;
#pragma unroll
  for (int i = 0; i < 2; ++i)
#pragma unroll
    for (int j = 0; j < 2; ++j)
#pragma unroll
      for (int e = 0; e < 16; ++e) acc[i][j][e] = 0.f;
  const int lrow = tid >> 3, lch = (tid & 7) * 8;
  const bf16_t* ga = A + (size_t)lrow * lda + lch;
  const bf16_t* gb = Bt + (size_t)lrow * ldb + lch;
  const int soff = lrow * LDT + lch;
  u32x4 ra[4], rb[4];
#pragma unroll
  for (int i = 0; i < 4; ++i) { ra[i] = *(const u32x4*)(ga + (size_t)i * 32 * lda); rb[i] = *(const u32x4*)(gb + (size_t)i * 32 * ldb); }
#pragma unroll
  for (int i = 0; i < 4; ++i) { *(u32x4*)(sA + soff + i * 32 * LDT) = ra[i]; *(u32x4*)(sB + soff + i * 32 * LDT) = rb[i]; }
  __syncthreads();
  const int nk = K >> 6;
  for (int kt = 0; kt < nk; ++kt) {
    const int cur = kt & 1;
    const bool more = kt + 1 < nk;
    if (more) {
      const int k0 = (kt + 1) * 64;
#pragma unroll
      for (int i = 0; i < 4; ++i) { ra[i] = *(const u32x4*)(ga + (size_t)i * 32 * lda + k0); rb[i] = *(const u32x4*)(gb + (size_t)i * 32 * ldb + k0); }
    }
    const bf16_t* ab = sA + cur * 128 * LDT + (64 * wr + l32) * LDT + h * 8;
    const bf16_t* bb = sB + cur * 128 * LDT + (64 * wc + l32) * LDT + h * 8;
    __builtin_amdgcn_s_setprio(1);
    __builtin_amdgcn_iglp_opt(0);
#pragma unroll
    for (int ks = 0; ks < 4; ++ks) {
      const bf16x8 a0 = *(const bf16x8*)(ab + ks * 16), a1 = *(const bf16x8*)(ab + 32 * LDT + ks * 16);
      const bf16x8 b0 = *(const bf16x8*)(bb + ks * 16), b1 = *(const bf16x8*)(bb + 32 * LDT + ks * 16);
      if (!SWAP) {
        acc[0][0] = MFMA(a0, b0, acc[0][0]); acc[0][1] = MFMA(a0, b1, acc[0][1]);
        acc[1][0] = MFMA(a1, b0, acc[1][0]); acc[1][1] = MFMA(a1, b1, acc[1][1]);
      } else {
        acc[0][0] = MFMA(b0, a0, acc[0][0]); acc[0][1] = MFMA(b1, a0, acc[0][1]);
        acc[1][0] = MFMA(b0, a1, acc[1][0]); acc[1][1] = MFMA(b1, a1, acc[1][1]);
      }
    }
    __builtin_amdgcn_s_setprio(0);
    if (more) {
      const int nb = (cur ^ 1) * 128 * LDT;
#pragma unroll
      for (int i = 0; i < 4; ++i) { *(u32x4*)(sA + nb + soff + i * 32 * LDT) = ra[i]; *(u32x4*)(sB + nb + soff + i * 32 * LDT) = rb[i]; }
    }
    __syncthreads();
  }
}

enum { E_RM64 = 0, E_VT, E_PLAIN, E_SILU, E_MISC, E_QUP_NOPE, E_QUP_ROPE, E_KVUP_K, E_KVUP_V, E_OUT };

struct GJob {
  const bf16_t* A; const bf16_t* Bt; int lda, ldb, K, m0, epi;
  bf16_t* dst; int ld, coloff, headbase, sshift; float scale; int rs_k;
};

DI float silu_f(float x) { return x * __builtin_amdgcn_rcpf(1.f + __builtin_amdgcn_exp2f(-x * LOG2E)); }

DI void gemm_job(PP p, int l, const GJob& J, char* smem) {
  bf16_t* sA = (bf16_t*)smem; bf16_t* sB = sA + 2 * 128 * LDT;
  float* sRS = (float*)(smem + SMEM_GEMM);
  const int tid = get_tid(), lane = tid & 63, wave = tid >> 6, wr = wave >> 1, wc = wave & 1, l32 = lane & 31, h = lane >> 5;
  if (J.rs_k) {
    const int row = tid >> 1, half = tid & 1, n = J.rs_k >> 1;
    const bf16_t* a = J.A + (size_t)row * J.lda + half * n;
    float ss = 0.f;
    for (int c = 0; c < n; c += 8) {
      u32x4 v = *(const u32x4*)(a + c);
#pragma unroll
      for (int e = 0; e < 4; ++e) { const float lo = __uint_as_float(v[e] << 16), hi = __uint_as_float(v[e] & 0xffff0000u); ss += lo * lo + hi * hi; }
    }
    ss += __shfl_xor(ss, 1);
    if (!half) sRS[row] = rsqrtf(ss / (float)J.rs_k + 1e-6f);
  }
  f32x16 acc[2][2];
  const bool normal = (J.epi == E_VT) || (J.epi == E_KVUP_V);
  if (normal) gemm_block<false>(J.A, J.lda, J.Bt, J.ldb, J.K, acc, sA, sB);
  else gemm_block<true>(J.A, J.lda, J.Bt, J.ldb, J.K, acc, sA, sB);
  const int smask = (1 << J.sshift) - 1;
  constexpr int LDO = 136;
  bf16_t* sO = (bf16_t*)smem;
  if (J.epi == 100) return;
  if (J.epi == E_MISC) {
    if (wc == 0) {
#pragma unroll
      for (int i = 0; i < 2; ++i) {
        const int tok = J.m0 + 64 * wr + 32 * i + l32;
        const int b = tok >> 13, s = tok & 8191;
#pragma unroll
        for (int g = 0; g < 2; ++g) {
          const int c = 8 * g + 4 * h;
          float y1[4], y2[4];
#pragma unroll
          for (int r = 0; r < 4; ++r) {
            const float2 cs = p->ropetab[s * 16 + c + r];
            const float x1 = acc[i][0][4 * g + r], x2 = acc[i][1][4 * g + r];
            y1[r] = x1 * cs.x - x2 * cs.y; y2[r] = x1 * cs.y + x2 * cs.x;
          }
          *(u32x2*)(p->krope + (size_t)tok * 32 + c) = pack4(y1[0], y1[1], y1[2], y1[3]);
          *(u32x2*)(p->krope + (size_t)tok * 32 + 16 + c) = pack4(y2[0], y2[1], y2[2], y2[3]);
        }
        if (h == 0) {
#pragma unroll
          for (int r = 0; r < 4; ++r) {
            const float xx = acc[i][0][8 + r] + p->b_forget[l * 4 + r];
            const float t = exp2f(-fabsf(xx) * LOG2E);
            const float lf = fminf(xx, 0.f) * LOG2E - log2f(1.f + t);
            p->logf[((size_t)(b * 4 + r) << 13) + s] = lf;
          }
        }
      }
    }
    return;
  }
  if (J.epi == E_OUT) {
    float* sOf = (float*)smem;
#pragma unroll
    for (int i = 0; i < 2; ++i) {
      const int mloc = 64 * wr + 32 * i + l32;
#pragma unroll
      for (int j = 0; j < 2; ++j)
#pragma unroll
        for (int g = 0; g < 4; ++g) {
          f32x4 v = {acc[i][j][4 * g], acc[i][j][4 * g + 1], acc[i][j][4 * g + 2], acc[i][j][4 * g + 3]};
          *(f32x4*)(sOf + mloc * 132 + 64 * wc + 32 * j + 8 * g + 4 * h) = v;
        }
    }
    __syncthreads();
#pragma unroll 8
    for (int it = 0; it < 16; ++it) {
      const int id = tid + 256 * it, r = id >> 5, c = id & 31;
      const f32x4 v = *(const f32x4*)(sOf + r * 132 + c * 4);
      const size_t eo = (size_t)(J.m0 + r) * 1024 + J.coloff + c * 4;
      const float* rsrc = l == 0 ? p->x : p->hres;
      const float2 st = (l == 0 ? p->stat0 : p->stat1)[J.m0 + r];
      const float* gp = l == 0 ? p->ln_in_g : p->ln_g;
      const float* bp = l == 0 ? p->ln_in_b : p->ln_b;
      const f32x4 xs = *(const f32x4*)(rsrc + eo);
      const f32x4 g4 = *(const f32x4*)(gp + J.coloff + c * 4), b4 = *(const f32x4*)(bp + J.coloff + c * 4);
      f32x4 res = ((xs - st.x) * st.y * g4 + b4) * ALPHA + v;
      *(f32x4*)(p->hres + eo) = res;
    }
    __syncthreads();
    return;
  }
  if (normal) {
#pragma unroll
    for (int i = 0; i < 2; ++i)
#pragma unroll
      for (int j = 0; j < 2; ++j)
#pragma unroll
        for (int g = 0; g < 4; ++g) {
          const int mloc = 64 * wr + 32 * i + 8 * g + 4 * h;
          const int pos = (mloc & ~12) | (h << 3) | ((g & 1) << 2);
          const int row = 64 * wc + 32 * j + l32;
          float v0 = acc[i][j][4 * g], v1 = acc[i][j][4 * g + 1], v2 = acc[i][j][4 * g + 2], v3 = acc[i][j][4 * g + 3];
          if (J.epi == E_KVUP_V) { v0 *= sRS[mloc]; v1 *= sRS[mloc + 1]; v2 *= sRS[mloc + 2]; v3 *= sRS[mloc + 3]; }
          *(u32x2*)(sO + row * LDO + pos) = pack4(v0, v1, v2, v3);
        }
  } else {
#pragma unroll
    for (int i = 0; i < 2; ++i) {
      const int mloc = 64 * wr + 32 * i + l32;
      float sc = J.scale;
      if (J.epi == E_QUP_NOPE || J.epi == E_QUP_ROPE) sc = sRS[mloc] * MLASCALE;
      if (J.epi == E_KVUP_K) sc = sRS[mloc];
      if (J.epi == E_QUP_ROPE) {
        const int s = (J.m0 + mloc) & 8191;
#pragma unroll
        for (int g = 0; g < 4; ++g) {
          const int c = 8 * g + 4 * h;
          const int head = 2 * wc + (c >> 4), ii = c & 15;
          float y1[4], y2[4];
#pragma unroll
          for (int r = 0; r < 4; ++r) {
            const float2 cs = p->ropetab[s * 16 + ii + r];
            const float x1 = acc[i][0][4 * g + r] * sc, x2 = acc[i][1][4 * g + r] * sc;
            y1[r] = x1 * cs.x - x2 * cs.y; y2[r] = x1 * cs.y + x2 * cs.x;
          }
          *(u32x2*)(sO + mloc * LDO + head * 32 + ii) = pack4(y1[0], y1[1], y1[2], y1[3]);
          *(u32x2*)(sO + mloc * LDO + head * 32 + 16 + ii) = pack4(y2[0], y2[1], y2[2], y2[3]);
        }
      } else {
#pragma unroll
        for (int j = 0; j < 2; ++j)
#pragma unroll
          for (int g = 0; g < 4; ++g) {
            float v0 = acc[i][j][4 * g], v1 = acc[i][j][4 * g + 1], v2 = acc[i][j][4 * g + 2], v3 = acc[i][j][4 * g + 3];
            if (J.epi == E_SILU) { v0 = silu_f(v0); v1 = silu_f(v1); v2 = silu_f(v2); v3 = silu_f(v3); }
            *(u32x2*)(sO + mloc * LDO + 64 * wc + 32 * j + 8 * g + 4 * h) = pack4(v0 * sc, v1 * sc, v2 * sc, v3 * sc);
          }
      }
    }
  }
  __syncthreads();
  {
    const int b0 = J.m0 >> J.sshift, s0 = J.m0 & smask;
#pragma unroll 2
    for (int it = 0; it < 8; ++it) {
      const int id = tid + 256 * it, r = id >> 4, c = id & 15;
      const u32x4 v = *(const u32x4*)(sO + r * LDO + c * 8);
      const int tok = J.m0 + r, b = tok >> J.sshift, s = tok & smask;
      bf16_t* q;
      switch (J.epi) {
        case E_RM64: q = J.dst + ((((size_t)(b * 4 + J.headbase + (c >> 3))) << J.sshift) + s) * 64 + (c & 7) * 8; break;
        case E_PLAIN: case E_SILU: q = J.dst + (size_t)tok * J.ld + J.coloff + c * 8; break;
        case E_QUP_NOPE: q = p->Qm + ((((size_t)(b * 4 + J.headbase + (c >> 3))) << 13) + s) * 96 + (c & 7) * 8; break;
        case E_QUP_ROPE: q = p->Qm + ((((size_t)(b * 4 + (c >> 2))) << 13) + s) * 96 + 64 + (c & 3) * 8; break;
        case E_KVUP_K: q = p->Km + ((((size_t)(b * 4 + J.headbase + (c >> 3))) << 13) + s) * 96 + (c & 7) * 8; break;
        default: q = J.dst + (((size_t)(b0 * 4 + J.headbase + (r >> 6)) * 64 + (r & 63)) << J.sshift) + s0 + c * 8; break;
      }
      *(u32x4*)q = v;
    }
  }
  if (J.epi == E_KVUP_K) {
#pragma unroll
    for (int i = 0; i < 4; ++i) {
      const int id = tid + 256 * i;
      const int row = id >> 3, hh = (id >> 2) & 1, ch = id & 3;
      const int tok = J.m0 + row, b = tok >> 13, s = tok & 8191;
      const u32x4 v = *(const u32x4*)(p->krope + (size_t)tok * 32 + ch * 8);
      *(u32x4*)(p->Km + (((size_t)(b * 4 + J.headbase + hh) << 13) + s) * 96 + 64 + ch * 8) = v;
    }
  }
  __syncthreads();
}

DI void phase1(PP p, int l, char* smem) {
  const int nmain = 256 * 26;
  const int njobs = nmain + (l == 0 ? 64 : 0);
  for (int job = blockIdx.x; job < njobs; job += gridDim.x) {
    GJob J;
    J.rs_k = 0; J.scale = 1.f; J.ld = 0; J.coloff = 0; J.headbase = 0; J.sshift = 13;
    if (job < nmain) {
      const int xcd = job & 7, q = job >> 3;
      const int sr = q / 208, rem = q - sr * 208;
      const int nt = rem >> 3, mt = (sr * 8 + (rem & 7)) * 8 + xcd;
      J.A = p->hb + (size_t)mt * 128 * 1024; J.lda = 1024;
      J.Bt = p->WinT + ((size_t)l * NP_ + nt * 128) * 1024; J.ldb = 1024; J.K = 1024; J.m0 = mt * 128;
      if (nt < 12) {
        const int grp = nt >> 1, sub = nt & 1;
        J.headbase = sub * 2;
        switch (grp) {
          case 0: J.epi = E_RM64; J.dst = p->Qf; J.scale = QSCALE; break;
          case 1: J.epi = E_RM64; J.dst = p->Kf; break;
          case 2: J.epi = E_VT; J.dst = p->Vtf; break;
          case 3: J.epi = E_RM64; J.dst = p->Qs; J.scale = QSCALE; break;
          case 4: J.epi = E_RM64; J.dst = p->Ks; break;
          default: J.epi = E_VT; J.dst = p->Vts; break;
        }
      } else if (nt < 14) { J.epi = E_PLAIN; J.dst = p->cq; J.ld = 256; J.coloff = (nt - 12) * 128; }
      else if (nt == 14) { J.epi = E_PLAIN; J.dst = p->ckv; J.ld = 128; J.coloff = 0; }
      else if (nt == 15) { J.epi = E_MISC; J.dst = nullptr; }
      else if (nt < 18) { J.epi = E_RM64; J.dst = p->Qx; J.scale = QSCALE; J.headbase = (nt - 16) * 2; }
      else { J.epi = E_SILU; J.dst = p->gs; J.ld = 1024; J.coloff = (nt - 18) * 128; }
    } else {
      const int j = job - nmain, ll = j >> 5, r = j & 31, mt = r >> 2, nt = r & 3;
      J.A = p->memn + (size_t)mt * 128 * 1024; J.lda = 1024;
      J.Bt = p->WmemT + ((size_t)ll * 512 + nt * 128) * 1024; J.ldb = 1024; J.K = 1024; J.m0 = mt * 128; J.sshift = 8;
      J.headbase = (nt & 1) * 2;
      if (nt < 2) { J.epi = E_RM64; J.dst = p->Kx + (size_t)ll * 16 * 256 * 64; }
      else { J.epi = E_VT; J.dst = p->Vtx + (size_t)ll * 16 * 256 * 64; }
    }
    gemm_job(p, l, J, smem);
  }
}

DI void phase2(PP p, int l, char* smem) {
  const int njobs = 16 + 256 * 7 + 512;
  for (int job = blockIdx.x; job < njobs; job += gridDim.x) {
    if (job >= 16 + 256 * 7) {
      const int tid = get_tid(), lane = tid & 63, wave = tid >> 6;
      const int t = (job - (16 + 256 * 7)) * 4 + wave;
      const bf16_t* kp = p->Kf + ((size_t)t * 64 + lane) * 64;
      float ss = 0.f;
#pragma unroll
      for (int c = 0; c < 8; ++c) {
        const u32x4 v = *(const u32x4*)(kp + c * 8);
#pragma unroll
        for (int e = 0; e < 4; ++e) { const float lo = __uint_as_float(v[e] << 16), hi = __uint_as_float(v[e] & 0xffff0000u); ss += lo * lo + hi * hi; }
      }
#pragma unroll
      for (int o = 32; o >= 1; o >>= 1) ss = fmaxf(ss, __shfl_xor(ss, o));
      if (lane == 0) p->knorm[t] = sqrtf(ss) * 1.0001f;
      continue;
    }
    if (job < 16) {
      const int tid = get_tid();
      const float* src = p->logf + (size_t)job * 8192 + tid * 32;
      float* dst = p->Fc + (size_t)job * 8192 + tid * 32;
      double* sd = (double*)smem;
      float v[32];
#pragma unroll
      for (int i = 0; i < 8; ++i) { f32x4 t = *(const f32x4*)(src + 4 * i); v[4 * i] = t.x; v[4 * i + 1] = t.y; v[4 * i + 2] = t.z; v[4 * i + 3] = t.w; }
      double tot = 0.0;
#pragma unroll
      for (int i = 0; i < 32; ++i) tot += (double)v[i];
      sd[tid] = tot;
      __syncthreads();
      for (int o = 1; o < 256; o <<= 1) {
        double a = sd[tid];
        if (tid >= o) a += sd[tid - o];
        __syncthreads();
        sd[tid] = a;
        __syncthreads();
      }
      double run = sd[tid] - tot;
#pragma unroll
      for (int i = 0; i < 8; ++i) {
        f32x4 t;
        run += (double)v[4 * i]; t.x = (float)run; run += (double)v[4 * i + 1]; t.y = (float)run;
        run += (double)v[4 * i + 2]; t.z = (float)run; run += (double)v[4 * i + 3]; t.w = (float)run;
        *(f32x4*)(dst + 4 * i) = t;
      }
      __syncthreads();
      continue;
    }
    const int j = job - 16, mt = j / 7, sub = j % 7;
    GJob J;
    J.scale = 1.f; J.ld = 0; J.coloff = 0; J.sshift = 13; J.dst = nullptr; J.m0 = mt * 128;
    if (sub < 3) {
      J.A = p->cq + (size_t)mt * 128 * 256; J.lda = 256; J.K = 256; J.rs_k = 256;
      J.Bt = p->WqupT + ((size_t)l * 384 + sub * 128) * 256; J.ldb = 256;
      J.headbase = sub * 2;
      J.epi = sub < 2 ? E_QUP_NOPE : E_QUP_ROPE;
    } else {
      const int nt = sub - 3;
      J.A = p->ckv + (size_t)mt * 128 * 128; J.lda = 128; J.K = 128; J.rs_k = 128;
      J.Bt = p->WkvupT + ((size_t)l * 512 + nt * 128) * 128; J.ldb = 128;
      J.headbase = (nt & 1) * 2;
      if (nt < 2) J.epi = E_KVUP_K; else { J.epi = E_KVUP_V; J.dst = p->Vtm; }
    }
    gemm_job(p, l, J, smem);
  }
}

DI void phase4(PP p, int l, char* smem) {
  const int njobs = 256 * 8;
  for (int job = blockIdx.x; job < njobs; job += gridDim.x) {
    const int xcd = job & 7, q = job >> 3;
    const int mt = (q >> 3) * 8 + xcd, nt = q & 7;
    GJob J;
    J.rs_k = 0; J.scale = 1.f; J.ld = 1024; J.headbase = 0; J.sshift = 13; J.dst = nullptr;
    J.A = p->mixedg + (size_t)mt * 128 * 1024; J.lda = 1024; J.K = 1024; J.m0 = mt * 128;
    J.Bt = p->WoutT + ((size_t)l * 1024 + nt * 128) * 1024; J.ldb = 1024;
    J.coloff = nt * 128; J.epi = E_OUT;
    gemm_job(p, l, J, smem);
  }
}

DI void phase5(PP p, int l, char* smem) {
  const int tid = get_tid(), lane = tid & 63, wave = tid >> 6;
  f32x4 gg[4], bb[4];
#pragma unroll
  for (int i = 0; i < 4; ++i) { gg[i] = *(const f32x4*)(p->ln_g + l * 1024 + (i * 64 + lane) * 4); bb[i] = *(const f32x4*)(p->ln_b + l * 1024 + (i * 64 + lane) * 4); }
  for (int job = blockIdx.x; job < 1024; job += gridDim.x) {
    for (int r = 0; r < 8; r += 4) {
      const size_t row = (size_t)job * 32 + wave * 8 + r;
      if (l == 0) ln_rows_wave<4>(p->hres + row * 1024, nullptr, p->hb + row * 1024, p->stat1 + row, gg, bb, lane);
      else ln_rows_wave<4, true, true>(p->hres + row * 1024, p->hres + row * 1024, nullptr, nullptr, gg, bb, lane);
    }
  }
}

template <int DK, int MODE>
DI void attn_job(const bf16_t* __restrict__ Q, const bf16_t* __restrict__ K, const bf16_t* __restrict__ Vt, const float* __restrict__ F, const float* __restrict__ KN,
                 int Skv, int qb, int ntiles, const bf16_t* __restrict__ gate, bf16_t* __restrict__ outp, char* smem) {
  constexpr int LDK = DK + 8, KCH = DK / 8, NKL = (64 * KCH) / 256, NKS = DK / 16;
  constexpr bool CAUSAL = MODE != 3;
  bf16_t* sK = (bf16_t*)smem;
  bf16_t* sV = sK + 2 * 64 * LDK;
  float* sF = (float*)(sV + 2 * 64 * 72);
  int* sFlag = (int*)(sF + 128);
  const int tid = get_tid(), lane = tid & 63, wave = __builtin_amdgcn_readfirstlane(tid >> 6), l32 = lane & 31, h = lane >> 5;
  const int tq0 = qb * 128 + 32 * wave;
  const int qpos = tq0 + l32;

  bf16x8 qf[NKS];
  {
    const bf16_t* qp = Q + (size_t)qpos * DK + h * 8;
#pragma unroll
    for (int ks = 0; ks < NKS; ++ks) qf[ks] = *(const bf16x8*)(qp + ks * 16);
#pragma unroll
    for (int ks = 0; ks < NKS; ++ks) asm volatile("" : "+v"(qf[ks]));
  }
  float Fref = 0.f;
  if (MODE == 1) Fref = F[qb * 128];

  f32x16 o0, o1;
#pragma unroll
  for (int e = 0; e < 16; ++e) { o0[e] = 0.f; o1[e] = 0.f; }
  float m = -1e30f, lsum = 0.f, R = 1.f;

  u32x4 rk[NKL], rv[2];
  float rf = 0.f;
  auto gload = [&](int jt) {
#pragma unroll
    for (int i = 0; i < NKL; ++i) {
      const int id = tid + 256 * i, row = id / KCH, ch = id % KCH;
      rk[i] = *(const u32x4*)(K + (size_t)(jt * 64 + row) * DK + ch * 8);
    }
#pragma unroll
    for (int i = 0; i < 2; ++i) {
      const int id = tid + 256 * i, row = id >> 3, ch = id & 7;
      rv[i] = *(const u32x4*)(Vt + (size_t)row * Skv + jt * 64 + ch * 8);
    }
    if (MODE == 1) rf = F[jt * 64 + (tid & 63)];
  };
  auto swrite = [&](int buf) {
#pragma unroll
    for (int i = 0; i < NKL; ++i) {
      const int id = tid + 256 * i, row = id / KCH, ch = id % KCH;
      *(u32x4*)(sK + buf * 64 * LDK + row * LDK + ch * 8) = rk[i];
    }
#pragma unroll
    for (int i = 0; i < 2; ++i) {
      const int id = tid + 256 * i, row = id >> 3, ch = id & 7;
      *(u32x4*)(sV + buf * 64 * 72 + row * 72 + ch * 8) = rv[i];
    }
    if (MODE == 1) { if (tid < 64) sF[buf * 64 + tid] = Fref - rf; }
  };

  constexpr bool ASC = MODE != 2;
  int start = 0;
  if (MODE == 1) {
    float qq = 0.f;
#pragma unroll
    for (int ks = 0; ks < NKS; ++ks)
#pragma unroll
      for (int e = 0; e < 8; ++e) { const float v = __uint_as_float(((unsigned)(unsigned short)qf[ks][e]) << 16); qq += v * v; }
    qq += __shfl_xor(qq, 32);
#pragma unroll
    for (int o = 16; o >= 1; o >>= 1) qq = fmaxf(qq, __shfl_xor(qq, o));
    int* sStart = sFlag + 8;
    float* sQN = (float*)(sFlag + 12);
    if (lane == 0) sQN[wave] = qq;
    if (tid == 0) *sStart = ntiles - 2;
    __syncthreads();
    const float qn = sqrtf(fmaxf(fmaxf(sQN[0], sQN[1]), fmaxf(sQN[2], sQN[3]))) * 1.0001f;
    if (tid < ntiles - 2) {
      const float kd = fmaxf(KN[ntiles - 1], KN[ntiles - 2]);
      const float ex = qn * (KN[tid] + kd) + Fref - F[tid * 64 + 63];
      if (!(ex < -64.f)) atomicMin(sStart, tid);
    }
    __syncthreads();
    start = *sStart;
  }
  const int nit = ntiles - start;
  gload(ASC ? start : ntiles - 1);
  swrite(0);
  __syncthreads();
  for (int it = 0; it < nit; ++it) {
    const int jt = ASC ? start + it : ntiles - 1 - it;
    const int cur = it & 1;
    const bool more = it + 1 < nit;
    if (more) gload(ASC ? jt + 1 : jt - 1);
    const int key0 = jt * 64;
    const bool active = !CAUSAL || (key0 <= tq0 + 31);
    if (active) {
      f32x16 s0, s1;
      const bf16_t* kb = sK + cur * 64 * LDK + l32 * LDK + h * 8;
      bf16x8 kf0[NKS], kf1[NKS];
#pragma unroll
      for (int ks = 0; ks < NKS; ++ks) { kf0[ks] = *(const bf16x8*)(kb + ks * 16); kf1[ks] = *(const bf16x8*)(kb + 32 * LDK + ks * 16); }
      if (MODE == 1) {
        const float* fb = sF + cur * 64 + 4 * h;
#pragma unroll
        for (int g = 0; g < 4; ++g) {
          const f32x4 f0 = *(const f32x4*)(fb + 8 * g), f1 = *(const f32x4*)(fb + 32 + 8 * g);
          s0[4 * g] = f0.x; s0[4 * g + 1] = f0.y; s0[4 * g + 2] = f0.z; s0[4 * g + 3] = f0.w;
          s1[4 * g] = f1.x; s1[4 * g + 1] = f1.y; s1[4 * g + 2] = f1.z; s1[4 * g + 3] = f1.w;
        }
      } else {
#pragma unroll
        for (int e = 0; e < 16; ++e) { s0[e] = 0.f; s1[e] = 0.f; }
      }
      __builtin_amdgcn_iglp_opt(0);
      __builtin_amdgcn_s_setprio(1);
#pragma unroll
      for (int ks = 0; ks < NKS; ++ks) { s0 = MFMA(kf0[ks], qf[ks], s0); s1 = MFMA(kf1[ks], qf[ks], s1); }
      __builtin_amdgcn_s_setprio(0);
      const bf16_t* vb = sV + cur * 64 * 72 + l32 * 72 + h * 8;
      bf16x8 vf0[4], vf1[4];
#pragma unroll
      for (int j = 0; j < 4; ++j) { vf0[j] = *(const bf16x8*)(vb + j * 16); vf1[j] = *(const bf16x8*)(vb + 32 * 72 + j * 16); }
      __builtin_amdgcn_sched_barrier(0);
      const bool need_mask = CAUSAL && (key0 + 63 >= tq0);
      bf16x8 pf[4];
      if (MODE != 2) {
        if (need_mask) {
#pragma unroll
          for (int e = 0; e < 16; ++e) {
            const int key = key0 + 8 * (e >> 2) + 4 * h + (e & 3);
            if (key > qpos) s0[e] = -1e30f;
            if (key + 32 > qpos) s1[e] = -1e30f;
          }
        }
        float mx = s0[0];
#pragma unroll
        for (int e = 1; e < 16; ++e) mx = fmaxf(mx, s0[e]);
#pragma unroll
        for (int e = 0; e < 16; ++e) mx = fmaxf(mx, s1[e]);
        mx = fmaxf(mx, __shfl_xor(mx, 32));
        if (__any(mx > m + 8.f)) {
          const float mnew = fmaxf(m, mx);
          const float alpha = __builtin_amdgcn_exp2f(m - mnew);
          m = mnew; lsum *= alpha;
#pragma unroll
          for (int e = 0; e < 16; ++e) { o0[e] *= alpha; o1[e] *= alpha; }
        }
        float ps0 = 0.f, ps1 = 0.f, ps2 = 0.f, ps3 = 0.f;
#pragma unroll
        for (int e = 0; e < 16; e += 4) {
          s0[e] = __builtin_amdgcn_exp2f(s0[e] - m); s0[e + 1] = __builtin_amdgcn_exp2f(s0[e + 1] - m); s0[e + 2] = __builtin_amdgcn_exp2f(s0[e + 2] - m); s0[e + 3] = __builtin_amdgcn_exp2f(s0[e + 3] - m);
          ps0 += s0[e]; ps1 += s0[e + 1]; ps2 += s0[e + 2]; ps3 += s0[e + 3];
        }
#pragma unroll
        for (int e = 0; e < 16; e += 4) {
          s1[e] = __builtin_amdgcn_exp2f(s1[e] - m); s1[e + 1] = __builtin_amdgcn_exp2f(s1[e + 1] - m); s1[e + 2] = __builtin_amdgcn_exp2f(s1[e + 2] - m); s1[e + 3] = __builtin_amdgcn_exp2f(s1[e + 3] - m);
          ps0 += s1[e]; ps1 += s1[e + 1]; ps2 += s1[e + 2]; ps3 += s1[e + 3];
        }
        lsum += (ps0 + ps1) + (ps2 + ps3);
      } else {
        f32x16 kp0, kp1;
#pragma unroll
        for (int e = 0; e < 16; ++e) {
          const float e0 = __builtin_amdgcn_exp2f(fminf(s0[e], 80.f)), e1 = __builtin_amdgcn_exp2f(fminf(s1[e], 80.f));
          kp0[e] = __builtin_amdgcn_rcpf(1.f + e0); kp1[e] = __builtin_amdgcn_rcpf(1.f + e1);
          s0[e] = e0 * kp0[e]; s1[e] = e1 * kp1[e];
        }
        if (need_mask) {
#pragma unroll
          for (int e = 0; e < 16; ++e) {
            const int key = key0 + 8 * (e >> 2) + 4 * h + (e & 3);
            if (key >= qpos) { kp0[e] = 1.f; s0[e] = 0.f; }
            if (key + 32 >= qpos) { kp1[e] = 1.f; s1[e] = 0.f; }
          }
        }
#pragma unroll
        for (int kt = 1; kt >= 0; --kt) {
          f32x16& kp = kt ? kp1 : kp0;
          f32x16& w = kt ? s1 : s0;
          float sfx[4][4];
#pragma unroll
          for (int g = 0; g < 4; ++g) {
            sfx[g][3] = kp[4 * g + 3];
            sfx[g][2] = kp[4 * g + 2] * sfx[g][3];
            sfx[g][1] = kp[4 * g + 1] * sfx[g][2];
            sfx[g][0] = kp[4 * g] * sfx[g][1];
          }
          float Gp[4], Dg[4];
#pragma unroll
          for (int g = 0; g < 4; ++g) { Gp[g] = __shfl_xor(sfx[g][0], 32); Dg[g] = sfx[g][0] * Gp[g]; }
          float E[4];
          E[3] = 1.f; E[2] = Dg[3]; E[1] = Dg[3] * Dg[2]; E[0] = E[1] * Dg[1];
          const float tot = E[0] * Dg[0];
#pragma unroll
          for (int g = 0; g < 4; ++g) {
            const float base = R * E[g] * (h == 0 ? Gp[g] : 1.f);
            w[4 * g + 3] *= base;
            w[4 * g + 2] *= base * sfx[g][3];
            w[4 * g + 1] *= base * sfx[g][2];
            w[4 * g] *= base * sfx[g][1];
          }
          R *= tot;
        }
      }
#pragma unroll
      for (int j = 0; j < 2; ++j) {
        u32x4 a, b;
        a.x = pack2(s0[8 * j], s0[8 * j + 1]); a.y = pack2(s0[8 * j + 2], s0[8 * j + 3]); a.z = pack2(s0[8 * j + 4], s0[8 * j + 5]); a.w = pack2(s0[8 * j + 6], s0[8 * j + 7]);
        b.x = pack2(s1[8 * j], s1[8 * j + 1]); b.y = pack2(s1[8 * j + 2], s1[8 * j + 3]); b.z = pack2(s1[8 * j + 4], s1[8 * j + 5]); b.w = pack2(s1[8 * j + 6], s1[8 * j + 7]);
        pf[j] = __builtin_bit_cast(bf16x8, a); pf[2 + j] = __builtin_bit_cast(bf16x8, b);
      }
      __builtin_amdgcn_s_setprio(1);
#pragma unroll
      for (int j = 0; j < 4; ++j) { o0 = MFMA(vf0[j], pf[j], o0); o1 = MFMA(vf1[j], pf[j], o1); }
      __builtin_amdgcn_s_setprio(0);
    }
    __builtin_amdgcn_sched_barrier(0);
    if (more) swrite(cur ^ 1);
    if (MODE == 2) { const int done = __all(R == 0.f); if (lane == 0) sFlag[cur * 4 + wave] = done; }
    __syncthreads();
    if (MODE == 2) { if (sFlag[cur * 4] & sFlag[cur * 4 + 1] & sFlag[cur * 4 + 2] & sFlag[cur * 4 + 3]) break; }
  }
  float inv = 1.f;
  if (MODE != 2) { const float lt = lsum + __shfl_xor(lsum, 32); inv = 1.f / lt; }
  const bf16_t* gp = gate + (size_t)qpos * 1024;
  bf16_t* op = outp + (size_t)qpos * 1024;
#pragma unroll
  for (int dt = 0; dt < 2; ++dt)
#pragma unroll
    for (int g = 0; g < 4; ++g) {
      const int dv = 32 * dt + 8 * g + 4 * h;
      const u32x2 gv = *(const u32x2*)(gp + dv);
      const f32x16& o = dt ? o1 : o0;
      const float g0 = __uint_as_float(gv.x << 16), g1 = __uint_as_float(gv.x & 0xffff0000u), g2 = __uint_as_float(gv.y << 16), g3 = __uint_as_float(gv.y & 0xffff0000u);
      *(u32x2*)(op + dv) = pack4(o[4 * g] * inv * g0, o[4 * g + 1] * inv * g1, o[4 * g + 2] * inv * g2, o[4 * g + 3] * inv * g3);
    }
  __syncthreads();
}

DI void phase3(PP p, int l, int cofs, char* smem) {
  const int xcd = blockIdx.x & 7, slot = blockIdx.x >> 3, nslots = gridDim.x >> 3;
  for (int pj = slot; pj < 128; pj += nslots) {
    const int k = pj >> 5, i = pj & 31;
    const int type = (k == 1 || k == 2) ? 1 : 0, bh = xcd * 2 + (k >> 1), b = bh >> 2, hd = bh & 3;
    const size_t tokbase = (size_t)b * S_ * 1024;
    for (int half = 0; half < 2; ++half) {
      const int qb = half ? 63 - i : i;
      if (type == 0) {
        const size_t off = (size_t)bh * S_ * 64;
        attn_job<64, 1>(p->Qf + off, p->Kf + off, p->Vtf + off, p->Fc + (size_t)bh * S_, p->knorm + bh * 128, S_, qb, 2 * (qb + 1),
                        p->gs + tokbase + hd * 64, p->mixedg + tokbase + hd * 64, smem);
      } else {
        attn_job<96, 0>(p->Qm + (size_t)bh * S_ * 96, p->Km + (size_t)bh * S_ * 96, p->Vtm + (size_t)bh * S_ * 64, nullptr, nullptr, S_, qb, 2 * (qb + 1),
                        p->gs + tokbase + 512 + hd * 64, p->mixedg + tokbase + 512 + hd * 64, smem);
      }
    }
  }
  for (int j = slot; j < 128; j += nslots) {
    const int bh = xcd * 2 + (j >> 6), qb = j & 63, b = bh >> 2, hd = bh & 3;
    const size_t tokbase = (size_t)b * S_ * 1024, off = (size_t)bh * S_ * 64;
    attn_job<64, 2>(p->Qs + off, p->Ks + off, p->Vts + off, nullptr, nullptr, S_, qb, 2 * (qb + 1),
                    p->gs + tokbase + 256 + hd * 64, p->mixedg + tokbase + 256 + hd * 64, smem);
    const size_t moff = ((size_t)l * 16 + bh) * 256 * 64;
    attn_job<64, 3>(p->Qx + off, p->Kx + moff, p->Vtx + moff, nullptr, nullptr, MEM_, qb, 4,
                    p->gs + tokbase + 768 + hd * 64, p->mixedg + tokbase + 768 + hd * 64, smem);
  }
}


#define XB_TMO      128
#define XB_XCNT(j)  (256  + 64 * (j))
#define XB_XSUB(j)  (1280 + 64 * (j))
#define XB_XGEN(j)  (2304 + 64 * (j))
#define XB_TOP      3328
#define XB_TOPGEN   3392
#define XB_SPIN_CAP (1u << 18)
DI unsigned xb_ld(unsigned* p)              { return __hip_atomic_load(p, __ATOMIC_RELAXED, __HIP_MEMORY_SCOPE_AGENT); }
DI unsigned xb_add(unsigned* p, unsigned v) { return __hip_atomic_fetch_add(p, v, __ATOMIC_RELAXED, __HIP_MEMORY_SCOPE_AGENT); }
DI unsigned xb_xcc_id() { return (unsigned)__builtin_amdgcn_s_getreg((3 << 11) | 20) & 0xFu; }
#define XB_SPIN(cond, bar) do { unsigned _sp = 0; while (cond) { __builtin_amdgcn_s_sleep(1); \
    if ((++_sp & 255u) == 0u) { if (xb_ld(&(bar)[XB_TMO])) break; if (_sp > XB_SPIN_CAP) { atomicAdd(&(bar)[XB_TMO], 1u); break; } } } } while (0)
struct XcdBarrier { unsigned* bar; unsigned x; volatile unsigned* st; };
DI XcdBarrier xcd_barrier_post(unsigned* bar, volatile unsigned* st) {
  XcdBarrier b; b.bar = bar; b.x = xb_xcc_id(); b.st = st;
  if (threadIdx.x == 0) (void)xb_add(&bar[XB_XCNT(b.x)], 1u);
  return b;
}
DI void xcd_barrier_complete(unsigned* bar, unsigned x, unsigned& nloc, unsigned& nx) {
  const unsigned G = gridDim.x * gridDim.y * gridDim.z;
  unsigned sum, cnt, mine, sp = 0u;
  for (;;) {
    sum = 0u; cnt = 0u; mine = 0u;
#pragma unroll
    for (unsigned j = 0; j < 16; ++j) { const unsigned c = xb_ld(&bar[XB_XCNT(j)]); sum += c; cnt += (c > 0u) ? 1u : 0u; mine = (j == x) ? c : mine; }
    if (sum == G) break;
    __builtin_amdgcn_s_sleep(1);
    if ((++sp & 255u) == 0u) { if (xb_ld(&bar[XB_TMO])) break; if (sp > XB_SPIN_CAP) { atomicAdd(&bar[XB_TMO], 1u); break; } }
  }
  nloc = mine > 0u ? mine : 1u; nx = cnt > 0u ? cnt : 1u;
}
DI void xcd_barrier(const XcdBarrier& b) {
  asm volatile("s_waitcnt vmcnt(0)" ::: "memory");
  __syncthreads();
  if (threadIdx.x == 0) {
    unsigned* bar = b.bar;
    __builtin_amdgcn_s_waitcnt(0);
    unsigned nloc = b.st[0], nx = b.st[1];
    if (nloc == 0u) { xcd_barrier_complete(bar, b.x, nloc, nx); b.st[0] = nloc; b.st[1] = nx; }
    const unsigned old = xb_add(&bar[XB_XSUB(b.x)], 1u);
    const unsigned gen = old / nloc;
    if (old + 1u == (gen + 1u) * nloc) {
      __builtin_amdgcn_fence(__ATOMIC_RELEASE, "agent");
      asm volatile("s_waitcnt vmcnt(0)" ::: "memory");
      const unsigned og = xb_add(&bar[XB_TOP], 1u);
      const unsigned tg = og / nx;
      if (og + 1u == (tg + 1u) * nx) xb_add(&bar[XB_TOPGEN], 1u);
      else XB_SPIN(xb_ld(&bar[XB_TOPGEN]) == tg, bar);
      __builtin_amdgcn_fence(__ATOMIC_ACQUIRE, "agent");
      xb_add(&bar[XB_XGEN(b.x)], 1u);
      asm volatile("s_waitcnt vmcnt(0)" ::: "memory");
    } else {
      XB_SPIN(xb_ld(&bar[XB_XGEN(b.x)]) == gen, bar);
      __builtin_amdgcn_fence(__ATOMIC_ACQUIRE, "agent");
      asm volatile("s_waitcnt vmcnt(0)" ::: "memory");
    }
  }
  __syncthreads();
}

__global__ void __launch_bounds__(256, 2) mega(Params p_unused) {
  __shared__ __attribute__((aligned(16))) char smem[SMEM_BYTES];
  PP p = (PP)__builtin_amdgcn_kernarg_segment_ptr();
  volatile unsigned* xst = (volatile unsigned*)(smem + SMEM_GEMM + 768);
  if (threadIdx.x == 0) { xst[0] = 0u; xst[1] = 0u; }
  __syncthreads();
  XcdBarrier xb = xcd_barrier_post(launder(p)->xbar, xst);
  if (launder(p)->x == nullptr) cg::this_grid().sync();
  phase0(launder(p), smem);
  xcd_barrier(xb);
  for (int l = 0; l < 2; ++l) {
    phase1(launder(p), l, smem); xcd_barrier(xb);
    phase2(launder(p), l, smem); xcd_barrier(xb);
    phase3(launder(p), l, 0, smem); xcd_barrier(xb);
    phase4(launder(p), l, smem); xcd_barrier(xb);
    phase5(launder(p), l, smem);
    if (l == 0) xcd_barrier(xb);
  }
}

extern "C" void kernel_launch(void* const* d_in, const int* in_sizes, int n_in, void* d_out, int out_size, void* d_ws, size_t ws_size, hipStream_t stream) {
  static int grid_blocks = 0;
  if (!grid_blocks) {
    int dev = 0, cus = 0, per_cu = 0;
    hipGetDevice(&dev);
    hipDeviceGetAttribute(&cus, hipDeviceAttributeMultiprocessorCount, dev);
    hipOccupancyMaxActiveBlocksPerMultiprocessor(&per_cu, mega, 256, 0);
    if (per_cu > 2) per_cu = 2;
    if (per_cu < 1) per_cu = 1;
    grid_blocks = cus * per_cu;
  }
  Params p{};
  p.x = (const float*)d_in[0]; p.mem = (const float*)d_in[1]; p.ln_in_g = (const float*)d_in[2]; p.ln_in_b = (const float*)d_in[3];
  p.mem_ln_g = (const float*)d_in[4]; p.mem_ln_b = (const float*)d_in[5]; p.w_in = (const float*)d_in[6]; p.b_forget = (const float*)d_in[7];
  p.q_norm_g = (const float*)d_in[8]; p.w_q_up = (const float*)d_in[9]; p.kv_norm_g = (const float*)d_in[10]; p.w_kv_up = (const float*)d_in[11];
  p.w_mem_kv = (const float*)d_in[12]; p.w_out = (const float*)d_in[13]; p.ln_g = (const float*)d_in[14]; p.ln_b = (const float*)d_in[15];
  p.hres = (float*)d_out;
  char* w = (char*)d_ws;
  size_t off = 0;
  auto take = [&](size_t bytes) { char* r = w + off; off += (bytes + 255) & ~(size_t)255; return r; };
  const size_t TB = (size_t)T_;
  p.hb = (bf16_t*)take(TB * 1024 * 2); p.mixedg = (bf16_t*)take(TB * 1024 * 2); p.gs = (bf16_t*)take(TB * 1024 * 2);
  p.memn = (bf16_t*)take((size_t)1024 * 1024 * 2);
  p.WinT = (bf16_t*)take((size_t)2 * NP_ * 1024 * 2); p.WmemT = (bf16_t*)take((size_t)2 * 512 * 1024 * 2);
  p.WqupT = (bf16_t*)take((size_t)2 * 384 * 256 * 2); p.WkvupT = (bf16_t*)take((size_t)2 * 512 * 128 * 2); p.WoutT = (bf16_t*)take((size_t)2 * 1024 * 1024 * 2);
  p.Qf = (bf16_t*)take(TB * 256 * 2); p.Kf = (bf16_t*)take(TB * 256 * 2); p.Vtf = (bf16_t*)take(TB * 256 * 2);
  p.Qs = (bf16_t*)take(TB * 256 * 2); p.Ks = (bf16_t*)take(TB * 256 * 2); p.Vts = (bf16_t*)take(TB * 256 * 2);
  p.Qm = (bf16_t*)take(TB * 384 * 2); p.Km = (bf16_t*)take(TB * 384 * 2); p.Vtm = (bf16_t*)take(TB * 256 * 2);
  p.Qx = (bf16_t*)take(TB * 256 * 2); p.Kx = (bf16_t*)take((size_t)2 * 16 * 256 * 64 * 2); p.Vtx = (bf16_t*)take((size_t)2 * 16 * 256 * 64 * 2);
  p.cq = (bf16_t*)take(TB * 256 * 2); p.ckv = (bf16_t*)take(TB * 128 * 2); p.krope = (bf16_t*)take(TB * 32 * 2);
  p.logf = (float*)take((size_t)16 * S_ * 4); p.Fc = (float*)take((size_t)16 * S_ * 4); p.knorm = (float*)take((size_t)16 * 128 * 4);
  p.ropetab = (float2*)take((size_t)S_ * 16 * 8);
  p.counters = (unsigned*)take(256);
  p.xbar = (unsigned*)take((size_t)XCD_BAR_WORDS * 4);
  p.stat0 = (float2*)take((size_t)T_ * 8); p.stat1 = (float2*)take((size_t)T_ * 8);
  if (off > ws_size) { fprintf(stderr, "workspace too small: need %zu have %zu\n", off, ws_size); return; }
  hipMemsetAsync(p.xbar, 0, (size_t)XCD_BAR_WORDS * 4, stream);
  void* args[] = {&p};
  hipError_t e = hipLaunchCooperativeKernel((void*)mega, dim3(grid_blocks), dim3(256), args, 0, stream);
  if (e != hipSuccess) fprintf(stderr, "cooperative launch failed: %s (grid %d)\n", hipGetErrorString(e), grid_blocks);
}
```

```cpp
#include <hip/hip_runtime.h>
#include <hip/hip_cooperative_groups.h>
#include <cstdio>
#include <cstdint>
namespace cg = cooperative_groups;

typedef unsigned short bf16_t;
typedef short bf16x8 __attribute__((ext_vector_type(8)));
typedef float f32x16 __attribute__((ext_vector_type(16)));
typedef float f32x4 __attribute__((ext_vector_type(4)));
typedef float f32x2 __attribute__((ext_vector_type(2)));
typedef __bf16 bf16v2 __attribute__((ext_vector_type(2)));
typedef unsigned u32x4 __attribute__((ext_vector_type(4)));
typedef unsigned u32x2 __attribute__((ext_vector_type(2)));

#define DI __device__ __forceinline__
#define XCD_BAR_WORDS 3456
#define MFMA(a, b, c) __builtin_amdgcn_mfma_f32_32x32x16_bf16((a), (b), (c), 0, 0, 0)

constexpr int B_ = 4, S_ = 8192, T_ = B_ * S_, D_ = 1024, NP_ = 3328, MEM_ = 256, INC_ = 3236;
constexpr float LOG2E = 1.4426950408889634f;
constexpr float QSCALE = 0.125f * LOG2E;
constexpr float MLASCALE = 0.10206207261596575f * LOG2E;
constexpr float ALPHA = 1.4142135623730951f;
constexpr int LDT = 72;
constexpr int SMEM_GEMM = 2 * 2 * 128 * LDT * 2;
constexpr int SMEM_BYTES = SMEM_GEMM + 1024;

struct Params {
  const float *x, *mem, *ln_in_g, *ln_in_b, *mem_ln_g, *mem_ln_b, *w_in, *b_forget, *q_norm_g, *w_q_up, *kv_norm_g, *w_kv_up, *w_mem_kv, *w_out, *ln_g, *ln_b;
  float* hres;
  bf16_t *hb, *mixedg, *gs, *memn;
  bf16_t *WinT, *WmemT, *WqupT, *WkvupT, *WoutT;
  bf16_t *Qf, *Kf, *Vtf, *Qs, *Ks, *Vts, *Qm, *Km, *Vtm, *Qx, *Kx, *Vtx;
  bf16_t *cq, *ckv, *krope;
  float *logf, *Fc, *knorm;
  float2* ropetab;
  unsigned* counters;
  unsigned* xbar;
  float2 *stat0, *stat1;
};

typedef const Params __attribute__((address_space(4)))* PP;
DI PP launder(PP p) { asm volatile("" : "+s"(p)); return p; }
DI int get_tid() { int t = threadIdx.x; asm volatile("" : "+v"(t)); return t; }
DI unsigned pack2(float a, float b) { f32x2 v = {a, b}; return __builtin_bit_cast(unsigned, __builtin_convertvector(v, bf16v2)); }
DI u32x2 pack4(float a, float b, float c, float d) { u32x2 r; r.x = pack2(a, b); r.y = pack2(c, d); return r; }
DI float bf2f(unsigned short x) { return __uint_as_float(((unsigned)x) << 16); }
DI float wave_sum(float v) {
#pragma unroll
  for (int o = 32; o >= 1; o >>= 1) v += __shfl_xor(v, o);
  return v;
}

DI void ln_row_wave(const float* src, float* dstf, bf16_t* dstb, const float* g, const float* bb, int lane) {
  f32x4 v[4];
#pragma unroll
  for (int i = 0; i < 4; ++i) v[i] = *(const f32x4*)(src + (i * 64 + lane) * 4);
  float s = 0.f;
#pragma unroll
  for (int i = 0; i < 4; ++i) s += v[i].x + v[i].y + v[i].z + v[i].w;
  s = wave_sum(s);
  const float mu = s * (1.f / 1024.f);
  float q = 0.f;
#pragma unroll
  for (int i = 0; i < 4; ++i) { f32x4 d = v[i] - mu; q += d.x * d.x + d.y * d.y + d.z * d.z + d.w * d.w; }
  q = wave_sum(q);
  const float rstd = rsqrtf(q * (1.f / 1024.f) + 1e-5f);
#pragma unroll
  for (int i = 0; i < 4; ++i) {
    const int c = (i * 64 + lane) * 4;
    f32x4 gg = *(const f32x4*)(g + c), b4 = *(const f32x4*)(bb + c);
    f32x4 y = (v[i] - mu) * rstd * gg + b4;
    if (dstf) *(f32x4*)(dstf + c) = y;
    if (dstb) *(u32x2*)(dstb + c) = pack4(y.x, y.y, y.z, y.w);
  }
}

template <int NR, bool NTL = false, bool NTS = false>
DI void ln_rows_wave(const float* src, float* dstf, bf16_t* dstb, float2* stats, const f32x4 (&gg)[4], const f32x4 (&bb)[4], int lane) {
  f32x4 v[NR][4];
#pragma unroll
  for (int r = 0; r < NR; ++r)
#pragma unroll
    for (int i = 0; i < 4; ++i) { const f32x4* sp = (const f32x4*)(src + (size_t)r * 1024 + (i * 64 + lane) * 4); v[r][i] = NTL ? __builtin_nontemporal_load(sp) : *sp; }
  float s[NR];
#pragma unroll
  for (int r = 0; r < NR; ++r) {
    s[r] = 0.f;
#pragma unroll
    for (int i = 0; i < 4; ++i) s[r] += v[r][i].x + v[r][i].y + v[r][i].z + v[r][i].w;
  }
#pragma unroll
  for (int o = 32; o >= 1; o >>= 1)
#pragma unroll
    for (int r = 0; r < NR; ++r) s[r] += __shfl_xor(s[r], o);
  float q[NR];
#pragma unroll
  for (int r = 0; r < NR; ++r) {
    const float mu = s[r] * (1.f / 1024.f);
    s[r] = mu; q[r] = 0.f;
#pragma unroll
    for (int i = 0; i < 4; ++i) { v[r][i] = v[r][i] - mu; q[r] += v[r][i].x * v[r][i].x + v[r][i].y * v[r][i].y + v[r][i].z * v[r][i].z + v[r][i].w * v[r][i].w; }
  }
#pragma unroll
  for (int o = 32; o >= 1; o >>= 1)
#pragma unroll
    for (int r = 0; r < NR; ++r) q[r] += __shfl_xor(q[r], o);
#pragma unroll
  for (int r = 0; r < NR; ++r) {
    const float rstd = rsqrtf(q[r] * (1.f / 1024.f) + 1e-5f);
    if (stats && lane == 0) { float2 st; st.x = s[r]; st.y = rstd; stats[r] = st; }
#pragma unroll
    for (int i = 0; i < 4; ++i) {
      const int c = (i * 64 + lane) * 4;
      const f32x4 y = v[r][i] * rstd * gg[i] + bb[i];
      if (dstf) { f32x4* dp = (f32x4*)(dstf + (size_t)r * 1024 + c); if (NTS) __builtin_nontemporal_store(y, dp); else *dp = y; }
      if (dstb) *(u32x2*)(dstb + (size_t)r * 1024 + c) = pack4(y.x, y.y, y.z, y.w);
    }
  }
}

DI int map_win(int n) {
  if (n < 768) return n;
  if (n < 1536) return n + 4;
  if (n < 1792) return n + 4;
  if (n < 1920) return n + 4;
  if (n < 2048) {
    const int j = n - 1920;
    if (j < 16) return 1924 + j;
    if (j < 20) return 768 + (j - 16);
    if (j < 32) return -1;
    if (j < 48) return 1924 + 16 + (j - 32);
    return -1;
  }
  if (n < 2304) return 1956 + (n - 2048);
  return 2212 + (n - 2304);
}
DI int map_qup(int n) {
  if (n < 256) return (n >> 6) * 96 + (n & 63);
  const int j = n - 256, blk = j >> 5, c = j & 31;
  const int head = (blk >> 1) * 2 + (c >> 4), isx2 = blk & 1, i = c & 15;
  return head * 96 + 64 + isx2 * 16 + i;
}
DI int map_kvup(int n) {
  if (n < 256) return (n >> 6) * 128 + (n & 63);
  const int m = n - 256;
  return (m >> 6) * 128 + 64 + (m & 63);
}

DI void wconv_tile(const float* __restrict__ src, int ldsrc, const float* __restrict__ rowscale, bf16_t* __restrict__ dst, int K, int k0, int n0, int kind, float* tile) {
  const int tid = get_tid();
  {
    const int c = tid & 63, kr = tid >> 6;
    const int n = n0 + c;
    const int col = kind == 0 ? map_win(n) : kind == 1 ? map_qup(n) : kind == 2 ? map_kvup(n) : n;
#pragma unroll 4
    for (int i = 0; i < 16; ++i) {
      const int k = kr + 4 * i;
      float v = 0.f;
      if (col >= 0) v = src[(size_t)(k0 + k) * ldsrc + col];
      if (rowscale) v *= rowscale[k0 + k];
      tile[k * 65 + c] = v;
    }
  }
  __syncthreads();
  {
    const int n = tid >> 2, kc = (tid & 3) * 16;
    float v[16];
#pragma unroll
    for (int e = 0; e < 16; ++e) v[e] = tile[(kc + e) * 65 + n];
    u32x4 a, b;
    a.x = pack2(v[0], v[1]); a.y = pack2(v[2], v[3]); a.z = pack2(v[4], v[5]); a.w = pack2(v[6], v[7]);
    b.x = pack2(v[8], v[9]); b.y = pack2(v[10], v[11]); b.z = pack2(v[12], v[13]); b.w = pack2(v[14], v[15]);
    bf16_t* d = dst + (size_t)(n0 + n) * K + k0 + kc;
    *(u32x4*)d = a; *(u32x4*)(d + 8) = b;
  }
  __syncthreads();
}

DI void phase0(PP p, char* smem) {
  const int tid = get_tid(), lane = tid & 63, wave = tid >> 6;
  if (blockIdx.x == 0 && tid < 8) p->counters[tid] = 0u;
  constexpr int J_LNX = 1024, J_LNM = 32, J_ROPE = 512, J_WIN = 2 * 16 * 52, J_WMEM = 2 * 16 * 8, J_QUP = 2 * 4 * 6, J_KVUP = 2 * 2 * 8, J_WOUT = 2 * 16 * 16;
  constexpr int NJ = J_LNX + J_LNM + J_ROPE + J_WIN + J_WMEM + J_QUP + J_KVUP + J_WOUT;
  float* tile = (float*)smem;
  for (int job = blockIdx.x; job < NJ; job += gridDim.x) {
    int j = job;
    if (j < J_LNX) {
      f32x4 gg[4], bb[4];
#pragma unroll
      for (int i = 0; i < 4; ++i) { gg[i] = *(const f32x4*)(p->ln_in_g + (i * 64 + lane) * 4); bb[i] = *(const f32x4*)(p->ln_in_b + (i * 64 + lane) * 4); }
      for (int r = 0; r < 8; r += 4) {
        const size_t row = (size_t)j * 32 + wave * 8 + r;
        ln_rows_wave<4, true, false>(p->x + row * 1024, nullptr, p->hb + row * 1024, p->stat0 + row, gg, bb, lane);
      }
      continue;
    }
    j -= J_LNX;
    if (j < J_LNM) {
      f32x4 gg[4], bb[4];
#pragma unroll
      for (int i = 0; i < 4; ++i) { gg[i] = *(const f32x4*)(p->mem_ln_g + (i * 64 + lane) * 4); bb[i] = *(const f32x4*)(p->mem_ln_b + (i * 64 + lane) * 4); }
      for (int r = 0; r < 8; r += 4) {
        const size_t row = (size_t)j * 32 + wave * 8 + r;
        ln_rows_wave<4, true, false>(p->mem + row * 1024, nullptr, p->memn + row * 1024, nullptr, gg, bb, lane);
      }
      continue;
    }
    j -= J_LNM;
    if (j < J_ROPE) {
      const int e = j * 256 + tid;
      const int s = e >> 4, i = e & 15;
      const float inv = exp2f(-(float)i * (13.287712379549449f / 16.f));
      const float ang = (float)s * inv;
      double rev = (double)ang * 0.15915494309189535;
      rev = rev - floor(rev);
      const float fr = (float)rev;
      float2 cs; cs.x = __builtin_amdgcn_cosf(fr); cs.y = __builtin_amdgcn_sinf(fr);
      p->ropetab[e] = cs;
      continue;
    }
    j -= J_ROPE;
    if (j < J_WIN) {
      const int l = j / 832, r = j % 832, kt = r / 52, nt = r % 52;
      wconv_tile(p->w_in + (size_t)l * 1024 * INC_, INC_, nullptr, p->WinT + (size_t)l * NP_ * 1024, 1024, kt * 64, nt * 64, 0, tile);
      continue;
    }
    j -= J_WIN;
    if (j < J_WMEM) {
      const int l = j / 128, r = j % 128, kt = r / 8, nt = r % 8;
      wconv_tile(p->w_mem_kv + (size_t)l * 1024 * 512, 512, nullptr, p->WmemT + (size_t)l * 512 * 1024, 1024, kt * 64, nt * 64, 3, tile);
      continue;
    }
    j -= J_WMEM;
    if (j < J_QUP) {
      const int l = j / 24, r = j % 24, kt = r / 6, nt = r % 6;
      wconv_tile(p->w_q_up + (size_t)l * 256 * 384, 384, p->q_norm_g + l * 256, p->WqupT + (size_t)l * 384 * 256, 256, kt * 64, nt * 64, 1, tile);
      continue;
    }
    j -= J_QUP;
    if (j < J_KVUP) {
      const int l = j / 16, r = j % 16, kt = r / 8, nt = r % 8;
      wconv_tile(p->w_kv_up + (size_t)l * 128 * 512, 512, p->kv_norm_g + l * 128, p->WkvupT + (size_t)l * 512 * 128, 128, kt * 64, nt * 64, 2, tile);
      continue;
    }
    j -= J_KVUP;
    {
      const int l = j / 256, r = j % 256, kt = r / 16, nt = r % 16;
      wconv_tile(p->w_out + (size_t)l * 1024 * 1024, 1024, nullptr, p->WoutT + (size_t)l * 1024 * 1024, 1024, kt * 64, nt * 64, 3, tile);
    }
  }
}

template <bool SWAP>
DI void gemm_block(const bf16_t* __restrict__ A, int lda, const bf16_t* __restrict__ Bt, int ldb, int K, f32x16 (&acc)[2][2], bf16_t* sA, bf16_t* sB) {
  const int tid = get_tid(), lane = tid & 63, wave = tid >> 6, wr = wave >> 1, wc = wave & 1, l32 = lane & 31, h = lane >> 5;
#pragma unroll
  for (int i = 0; i < 2; ++i)
#pragma unroll
    for (int j = 0; j < 2; ++j)
#pragma unroll
      for (int e = 0; e < 16; ++e) acc[i][j][e] = 0.f;
  const int lrow = tid >> 3, lch = (tid & 7) * 8;
  const bf16_t* ga = A + (size_t)lrow * lda + lch;
  const bf16_t* gb = Bt + (size_t)lrow * ldb + lch;
  const int soff = lrow * LDT + lch;
  u32x4 ra[4], rb[4];
#pragma unroll
  for (int i = 0; i < 4; ++i) { ra[i] = *(const u32x4*)(ga + (size_t)i * 32 * lda); rb[i] = *(const u32x4*)(gb + (size_t)i * 32 * ldb); }
#pragma unroll
  for (int i = 0; i < 4; ++i) { *(u32x4*)(sA + soff + i * 32 * LDT) = ra[i]; *(u32x4*)(sB + soff + i * 32 * LDT) = rb[i]; }
  __syncthreads();
  const int nk = K >> 6;
  for (int kt = 0; kt < nk; ++kt) {
    const int cur = kt & 1;
    const bool more = kt + 1 < nk;
    if (more) {
      const int k0 = (kt + 1) * 64;
#pragma unroll
      for (int i = 0; i < 4; ++i) { ra[i] = *(const u32x4*)(ga + (size_t)i * 32 * lda + k0); rb[i] = *(const u32x4*)(gb + (size_t)i * 32 * ldb + k0); }
    }
    const bf16_t* ab = sA + cur * 128 * LDT + (64 * wr + l32) * LDT + h * 8;
    const bf16_t* bb = sB + cur * 128 * LDT + (64 * wc + l32) * LDT + h * 8;
    __builtin_amdgcn_s_setprio(1);
    __builtin_amdgcn_iglp_opt(0);
#pragma unroll
    for (int ks = 0; ks < 4; ++ks) {
      const bf16x8 a0 = *(const bf16x8*)(ab + ks * 16), a1 = *(const bf16x8*)(ab + 32 * LDT + ks * 16);
      const bf16x8 b0 = *(const bf16x8*)(bb + ks * 16), b1 = *(const bf16x8*)(bb + 32 * LDT + ks * 16);
      if (!SWAP) {
        acc[0][0] = MFMA(a0, b0, acc[0][0]); acc[0][1] = MFMA(a0, b1, acc[0][1]);
        acc[1][0] = MFMA(a1, b0, acc[1][0]); acc[1][1] = MFMA(a1, b1, acc[1][1]);
      } else {
        acc[0][0] = MFMA(b0, a0, acc[0][0]); acc[0][1] = MFMA(b1, a0, acc[0][1]);
        acc[1][0] = MFMA(b0, a1, acc[1][0]); acc[1][1] = MFMA(b1, a1, acc[1][1]);
      }
    }
    __builtin_amdgcn_s_setprio(0);
    if (more) {
      const int nb = (cur ^ 1) * 128 * LDT;
#pragma unroll
      for (int i = 0; i < 4; ++i) { *(u32x4*)(sA + nb + soff + i * 32 * LDT) = ra[i]; *(u32x4*)(sB + nb + soff + i * 32 * LDT) = rb[i]; }
    }
    __syncthreads();
  }
}

enum { E_RM64 = 0, E_VT, E_PLAIN, E_SILU, E_MISC, E_QUP_NOPE, E_QUP_ROPE, E_KVUP_K, E_KVUP_V, E_OUT };

struct GJob {
  const bf16_t* A; const bf16_t* Bt; int lda, ldb, K, m0, epi;
  bf16_t* dst; int ld, coloff, headbase, sshift; float scale; int rs_k;
};

DI float silu_f(float x) { return x * __builtin_amdgcn_rcpf(1.f + __builtin_amdgcn_exp2f(-x * LOG2E)); }

DI void gemm_job(PP p, int l, const GJob& J, char* smem) {
  bf16_t* sA = (bf16_t*)smem; bf16_t* sB = sA + 2 * 128 * LDT;
  float* sRS = (float*)(smem + SMEM_GEMM);
  const int tid = get_tid(), lane = tid & 63, wave = tid >> 6, wr = wave >> 1, wc = wave & 1, l32 = lane & 31, h = lane >> 5;
  if (J.rs_k) {
    const int row = tid >> 1, half = tid & 1, n = J.rs_k >> 1;
    const bf16_t* a = J.A + (size_t)row * J.lda + half * n;
    float ss = 0.f;
    for (int c = 0; c < n; c += 8) {
      u32x4 v = *(const u32x4*)(a + c);
#pragma unroll
      for (int e = 0; e < 4; ++e) { const float lo = __uint_as_float(v[e] << 16), hi = __uint_as_float(v[e] & 0xffff0000u); ss += lo * lo + hi * hi; }
    }
    ss += __shfl_xor(ss, 1);
    if (!half) sRS[row] = rsqrtf(ss / (float)J.rs_k + 1e-6f);
  }
  f32x16 acc[2][2];
  const bool normal = (J.epi == E_VT) || (J.epi == E_KVUP_V);
  if (normal) gemm_block<false>(J.A, J.lda, J.Bt, J.ldb, J.K, acc, sA, sB);
  else gemm_block<true>(J.A, J.lda, J.Bt, J.ldb, J.K, acc, sA, sB);
  const int smask = (1 << J.sshift) - 1;
  constexpr int LDO = 136;
  bf16_t* sO = (bf16_t*)smem;
  if (J.epi == 100) return;
  if (J.epi == E_MISC) {
    if (wc == 0) {
#pragma unroll
      for (int i = 0; i < 2; ++i) {
        const int tok = J.m0 + 64 * wr + 32 * i + l32;
        const int b = tok >> 13, s = tok & 8191;
#pragma unroll
        for (int g = 0; g < 2; ++g) {
          const int c = 8 * g + 4 * h;
          float y1[4], y2[4];
#pragma unroll
          for (int r = 0; r < 4; ++r) {
            const float2 cs = p->ropetab[s * 16 + c + r];
            const float x1 = acc[i][0][4 * g + r], x2 = acc[i][1][4 * g + r];
            y1[r] = x1 * cs.x - x2 * cs.y; y2[r] = x1 * cs.y + x2 * cs.x;
          }
          *(u32x2*)(p->krope + (size_t)tok * 32 + c) = pack4(y1[0], y1[1], y1[2], y1[3]);
          *(u32x2*)(p->krope + (size_t)tok * 32 + 16 + c) = pack4(y2[0], y2[1], y2[2], y2[3]);
        }
        if (h == 0) {
#pragma unroll
          for (int r = 0; r < 4; ++r) {
            const float xx = acc[i][0][8 + r] + p->b_forget[l * 4 + r];
            const float t = exp2f(-fabsf(xx) * LOG2E);
            const float lf = fminf(xx, 0.f) * LOG2E - log2f(1.f + t);
            p->logf[((size_t)(b * 4 + r) << 13) + s] = lf;
          }
        }
      }
    }
    return;
  }
  if (J.epi == E_OUT) {
    float* sOf = (float*)smem;
#pragma unroll
    for (int i = 0; i < 2; ++i) {
      const int mloc = 64 * wr + 32 * i + l32;
#pragma unroll
      for (int j = 0; j < 2; ++j)
#pragma unroll
        for (int g = 0; g < 4; ++g) {
          f32x4 v = {acc[i][j][4 * g], acc[i][j][4 * g + 1], acc[i][j][4 * g + 2], acc[i][j][4 * g + 3]};
          *(f32x4*)(sOf + mloc * 132 + 64 * wc + 32 * j + 8 * g + 4 * h) = v;
        }
    }
    __syncthreads();
#pragma unroll 4
    for (int it = 0; it < 16; ++it) {
      const int id = tid + 256 * it, r = id >> 5, c = id & 31;
      const f32x4 v = *(const f32x4*)(sOf + r * 132 + c * 4);
      const size_t eo = (size_t)(J.m0 + r) * 1024 + J.coloff + c * 4;
      const float* rsrc = l == 0 ? p->x : p->hres;
      const float2 st = (l == 0 ? p->stat0 : p->stat1)[J.m0 + r];
      const float* gp = l == 0 ? p->ln_in_g : p->ln_g;
      const float* bp = l == 0 ? p->ln_in_b : p->ln_b;
      const f32x4 xs = *(const f32x4*)(rsrc + eo);
      const f32x4 g4 = *(const f32x4*)(gp + J.coloff + c * 4), b4 = *(const f32x4*)(bp + J.coloff + c * 4);
      f32x4 res = ((xs - st.x) * st.y * g4 + b4) * ALPHA + v;
      *(f32x4*)(p->hres + eo) = res;
    }
    __syncthreads();
    return;
  }
  if (normal) {
#pragma unroll
    for (int i = 0; i < 2; ++i)
#pragma unroll
      for (int j = 0; j < 2; ++j)
#pragma unroll
        for (int g = 0; g < 4; ++g) {
          const int mloc = 64 * wr + 32 * i + 8 * g + 4 * h;
          const int pos = (mloc & ~12) | (h << 3) | ((g & 1) << 2);
          const int row = 64 * wc + 32 * j + l32;
          float v0 = acc[i][j][4 * g], v1 = acc[i][j][4 * g + 1], v2 = acc[i][j][4 * g + 2], v3 = acc[i][j][4 * g + 3];
          if (J.epi == E_KVUP_V) { v0 *= sRS[mloc]; v1 *= sRS[mloc + 1]; v2 *= sRS[mloc + 2]; v3 *= sRS[mloc + 3]; }
          *(u32x2*)(sO + row * LDO + pos) = pack4(v0, v1, v2, v3);
        }
  } else {
#pragma unroll
    for (int i = 0; i < 2; ++i) {
      const int mloc = 64 * wr + 32 * i + l32;
      float sc = J.scale;
      if (J.epi == E_QUP_NOPE || J.epi == E_QUP_ROPE) sc = sRS[mloc] * MLASCALE;
      if (J.epi == E_KVUP_K) sc = sRS[mloc];
      if (J.epi == E_QUP_ROPE) {
        const int s = (J.m0 + mloc) & 8191;
#pragma unroll
        for (int g = 0; g < 4; ++g) {
          const int c = 8 * g + 4 * h;
          const int head = 2 * wc + (c >> 4), ii = c & 15;
          float y1[4], y2[4];
#pragma unroll
          for (int r = 0; r < 4; ++r) {
            const float2 cs = p->ropetab[s * 16 + ii + r];
            const float x1 = acc[i][0][4 * g + r] * sc, x2 = acc[i][1][4 * g + r] * sc;
            y1[r] = x1 * cs.x - x2 * cs.y; y2[r] = x1 * cs.y + x2 * cs.x;
          }
          *(u32x2*)(sO + mloc * LDO + head * 32 + ii) = pack4(y1[0], y1[1], y1[2], y1[3]);
          *(u32x2*)(sO + mloc * LDO + head * 32 + 16 + ii) = pack4(y2[0], y2[1], y2[2], y2[3]);
        }
      } else {
#pragma unroll
        for (int j = 0; j < 2; ++j)
#pragma unroll
          for (int g = 0; g < 4; ++g) {
            float v0 = acc[i][j][4 * g], v1 = acc[i][j][4 * g + 1], v2 = acc[i][j][4 * g + 2], v3 = acc[i][j][4 * g + 3];
            if (J.epi == E_SILU) { v0 = silu_f(v0); v1 = silu_f(v1); v2 = silu_f(v2); v3 = silu_f(v3); }
            *(u32x2*)(sO + mloc * LDO + 64 * wc + 32 * j + 8 * g + 4 * h) = pack4(v0 * sc, v1 * sc, v2 * sc, v3 * sc);
          }
      }
    }
  }
  __syncthreads();
  {
    const int b0 = J.m0 >> J.sshift, s0 = J.m0 & smask;
#pragma unroll 2
    for (int it = 0; it < 8; ++it) {
      const int id = tid + 256 * it, r = id >> 4, c = id & 15;
      const u32x4 v = *(const u32x4*)(sO + r * LDO + c * 8);
      const int tok = J.m0 + r, b = tok >> J.sshift, s = tok & smask;
      bf16_t* q;
      switch (J.epi) {
        case E_RM64: q = J.dst + ((((size_t)(b * 4 + J.headbase + (c >> 3))) << J.sshift) + s) * 64 + (c & 7) * 8; break;
        case E_PLAIN: case E_SILU: q = J.dst + (size_t)tok * J.ld + J.coloff + c * 8; break;
        case E_QUP_NOPE: q = p->Qm + ((((size_t)(b * 4 + J.headbase + (c >> 3))) << 13) + s) * 96 + (c & 7) * 8; break;
        case E_QUP_ROPE: q = p->Qm + ((((size_t)(b * 4 + (c >> 2))) << 13) + s) * 96 + 64 + (c & 3) * 8; break;
        case E_KVUP_K: q = p->Km + ((((size_t)(b * 4 + J.headbase + (c >> 3))) << 13) + s) * 96 + (c & 7) * 8; break;
        default: q = J.dst + (((size_t)(b0 * 4 + J.headbase + (r >> 6)) * 64 + (r & 63)) << J.sshift) + s0 + c * 8; break;
      }
      *(u32x4*)q = v;
    }
  }
  if (J.epi == E_KVUP_K) {
#pragma unroll
    for (int i = 0; i < 4; ++i) {
      const int id = tid + 256 * i;
      const int row = id >> 3, hh = (id >> 2) & 1, ch = id & 3;
      const int tok = J.m0 + row, b = tok >> 13, s = tok & 8191;
      const u32x4 v = *(const u32x4*)(p->krope + (size_t)tok * 32 + ch * 8);
      *(u32x4*)(p->Km + (((size_t)(b * 4 + J.headbase + hh) << 13) + s) * 96 + 64 + ch * 8) = v;
    }
  }
  __syncthreads();
}

DI void phase1(PP p, int l, char* smem) {
  const int nmain = 256 * 26;
  const int njobs = nmain + (l == 0 ? 64 : 0);
  for (int job = blockIdx.x; job < njobs; job += gridDim.x) {
    GJob J;
    J.rs_k = 0; J.scale = 1.f; J.ld = 0; J.coloff = 0; J.headbase = 0; J.sshift = 13;
    if (job < nmain) {
      const int xcd = job & 7, q = job >> 3;
      const int sr = q / 208, rem = q - sr * 208;
      const int nt = rem >> 3, mt = (sr * 8 + (rem & 7)) * 8 + xcd;
      J.A = p->hb + (size_t)mt * 128 * 1024; J.lda = 1024;
      J.Bt = p->WinT + ((size_t)l * NP_ + nt * 128) * 1024; J.ldb = 1024; J.K = 1024; J.m0 = mt * 128;
      if (nt < 12) {
        const int grp = nt >> 1, sub = nt & 1;
        J.headbase = sub * 2;
        switch (grp) {
          case 0: J.epi = E_RM64; J.dst = p->Qf; J.scale = QSCALE; break;
          case 1: J.epi = E_RM64; J.dst = p->Kf; break;
          case 2: J.epi = E_VT; J.dst = p->Vtf; break;
          case 3: J.epi = E_RM64; J.dst = p->Qs; J.scale = QSCALE; break;
          case 4: J.epi = E_RM64; J.dst = p->Ks; break;
          default: J.epi = E_VT; J.dst = p->Vts; break;
        }
      } else if (nt < 14) { J.epi = E_PLAIN; J.dst = p->cq; J.ld = 256; J.coloff = (nt - 12) * 128; }
      else if (nt == 14) { J.epi = E_PLAIN; J.dst = p->ckv; J.ld = 128; J.coloff = 0; }
      else if (nt == 15) { J.epi = E_MISC; J.dst = nullptr; }
      else if (nt < 18) { J.epi = E_RM64; J.dst = p->Qx; J.scale = QSCALE; J.headbase = (nt - 16) * 2; }
      else { J.epi = E_SILU; J.dst = p->gs; J.ld = 1024; J.coloff = (nt - 18) * 128; }
    } else {
      const int j = job - nmain, ll = j >> 5, r = j & 31, mt = r >> 2, nt = r & 3;
      J.A = p->memn + (size_t)mt * 128 * 1024; J.lda = 1024;
      J.Bt = p->WmemT + ((size_t)ll * 512 + nt * 128) * 1024; J.ldb = 1024; J.K = 1024; J.m0 = mt * 128; J.sshift = 8;
      J.headbase = (nt & 1) * 2;
      if (nt < 2) { J.epi = E_RM64; J.dst = p->Kx + (size_t)ll * 16 * 256 * 64; }
      else { J.epi = E_VT; J.dst = p->Vtx + (size_t)ll * 16 * 256 * 64; }
    }
    gemm_job(p, l, J, smem);
  }
}

DI void phase2(PP p, int l, char* smem) {
  const int njobs = 16 + 256 * 7 + 512;
  for (int job = blockIdx.x; job < njobs; job += gridDim.x) {
    if (job >= 16 + 256 * 7) {
      const int tid = get_tid(), lane = tid & 63, wave = tid >> 6;
      const int t = (job - (16 + 256 * 7)) * 4 + wave;
      const bf16_t* kp = p->Kf + ((size_t)t * 64 + lane) * 64;
      float ss = 0.f;
#pragma unroll
      for (int c = 0; c < 8; ++c) {
        const u32x4 v = *(const u32x4*)(kp + c * 8);
#pragma unroll
        for (int e = 0; e < 4; ++e) { const float lo = __uint_as_float(v[e] << 16), hi = __uint_as_float(v[e] & 0xffff0000u); ss += lo * lo + hi * hi; }
      }
#pragma unroll
      for (int o = 32; o >= 1; o >>= 1) ss = fmaxf(ss, __shfl_xor(ss, o));
      if (lane == 0) p->knorm[t] = sqrtf(ss) * 1.0001f;
      continue;
    }
    if (job < 16) {
      const int tid = get_tid();
      const float* src = p->logf + (size_t)job * 8192 + tid * 32;
      float* dst = p->Fc + (size_t)job * 8192 + tid * 32;
      double* sd = (double*)smem;
      float v[32];
#pragma unroll
      for (int i = 0; i < 8; ++i) { f32x4 t = *(const f32x4*)(src + 4 * i); v[4 * i] = t.x; v[4 * i + 1] = t.y; v[4 * i + 2] = t.z; v[4 * i + 3] = t.w; }
      double tot = 0.0;
#pragma unroll
      for (int i = 0; i < 32; ++i) tot += (double)v[i];
      sd[tid] = tot;
      __syncthreads();
      for (int o = 1; o < 256; o <<= 1) {
        double a = sd[tid];
        if (tid >= o) a += sd[tid - o];
        __syncthreads();
        sd[tid] = a;
        __syncthreads();
      }
      double run = sd[tid] - tot;
#pragma unroll
      for (int i = 0; i < 8; ++i) {
        f32x4 t;
        run += (double)v[4 * i]; t.x = (float)run; run += (double)v[4 * i + 1]; t.y = (float)run;
        run += (double)v[4 * i + 2]; t.z = (float)run; run += (double)v[4 * i + 3]; t.w = (float)run;
        *(f32x4*)(dst + 4 * i) = t;
      }
      __syncthreads();
      continue;
    }
    const int j = job - 16, mt = j / 7, sub = j % 7;
    GJob J;
    J.scale = 1.f; J.ld = 0; J.coloff = 0; J.sshift = 13; J.dst = nullptr; J.m0 = mt * 128;
    if (sub < 3) {
      J.A = p->cq + (size_t)mt * 128 * 256; J.lda = 256; J.K = 256; J.rs_k = 256;
      J.Bt = p->WqupT + ((size_t)l * 384 + sub * 128) * 256; J.ldb = 256;
      J.headbase = sub * 2;
      J.epi = sub < 2 ? E_QUP_NOPE : E_QUP_ROPE;
    } else {
      const int nt = sub - 3;
      J.A = p->ckv + (size_t)mt * 128 * 128; J.lda = 128; J.K = 128; J.rs_k = 128;
      J.Bt = p->WkvupT + ((size_t)l * 512 + nt * 128) * 128; J.ldb = 128;
      J.headbase = (nt & 1) * 2;
      if (nt < 2) J.epi = E_KVUP_K; else { J.epi = E_KVUP_V; J.dst = p->Vtm; }
    }
    gemm_job(p, l, J, smem);
  }
}

DI void phase4(PP p, int l, char* smem) {
  const int njobs = 256 * 8;
  for (int job = blockIdx.x; job < njobs; job += gridDim.x) {
    const int xcd = job & 7, q = job >> 3;
    const int mt = (q >> 3) * 8 + xcd, nt = q & 7;
    GJob J;
    J.rs_k = 0; J.scale = 1.f; J.ld = 1024; J.headbase = 0; J.sshift = 13; J.dst = nullptr;
    J.A = p->mixedg + (size_t)mt * 128 * 1024; J.lda = 1024; J.K = 1024; J.m0 = mt * 128;
    J.Bt = p->WoutT + ((size_t)l * 1024 + nt * 128) * 1024; J.ldb = 1024;
    J.coloff = nt * 128; J.epi = E_OUT;
    gemm_job(p, l, J, smem);
  }
}

DI void phase5(PP p, int l, char* smem) {
  const int tid = get_tid(), lane = tid & 63, wave = tid >> 6;
  f32x4 gg[4], bb[4];
#pragma unroll
  for (int i = 0; i < 4; ++i) { gg[i] = *(const f32x4*)(p->ln_g + l * 1024 + (i * 64 + lane) * 4); bb[i] = *(const f32x4*)(p->ln_b + l * 1024 + (i * 64 + lane) * 4); }
  for (int job = blockIdx.x; job < 1024; job += gridDim.x) {
    for (int r = 0; r < 8; r += 4) {
      const size_t row = (size_t)job * 32 + wave * 8 + r;
      if (l == 0) ln_rows_wave<4>(p->hres + row * 1024, nullptr, p->hb + row * 1024, p->stat1 + row, gg, bb, lane);
      else ln_rows_wave<4, true, true>(p->hres + row * 1024, p->hres + row * 1024, nullptr, nullptr, gg, bb, lane);
    }
  }
}

template <int DK, int MODE>
DI void attn_job(const bf16_t* __restrict__ Q, const bf16_t* __restrict__ K, const bf16_t* __restrict__ Vt, const float* __restrict__ F, const float* __restrict__ KN,
                 int Skv, int qb, int ntiles, const bf16_t* __restrict__ gate, bf16_t* __restrict__ outp, char* smem) {
  constexpr int LDK = DK + 8, KCH = DK / 8, NKL = (64 * KCH) / 256, NKS = DK / 16;
  constexpr bool CAUSAL = MODE != 3;
  bf16_t* sK = (bf16_t*)smem;
  bf16_t* sV = sK + 2 * 64 * LDK;
  float* sF = (float*)(sV + 2 * 64 * 72);
  int* sFlag = (int*)(sF + 128);
  const int tid = get_tid(), lane = tid & 63, wave = __builtin_amdgcn_readfirstlane(tid >> 6), l32 = lane & 31, h = lane >> 5;
  const int tq0 = qb * 128 + 32 * wave;
  const int qpos = tq0 + l32;

  bf16x8 qf[NKS];
  {
    const bf16_t* qp = Q + (size_t)qpos * DK + h * 8;
#pragma unroll
    for (int ks = 0; ks < NKS; ++ks) qf[ks] = *(const bf16x8*)(qp + ks * 16);
#pragma unroll
    for (int ks = 0; ks < NKS; ++ks) asm volatile("" : "+v"(qf[ks]));
  }
  float Fref = 0.f;
  if (MODE == 1) Fref = F[qb * 128];

  f32x16 o0, o1;
#pragma unroll
  for (int e = 0; e < 16; ++e) { o0[e] = 0.f; o1[e] = 0.f; }
  float m = -1e30f, lsum = 0.f, R = 1.f;

  u32x4 rk[NKL], rv[2];
  float rf = 0.f;
  auto gload = [&](int jt) {
#pragma unroll
    for (int i = 0; i < NKL; ++i) {
      const int id = tid + 256 * i, row = id / KCH, ch = id % KCH;
      rk[i] = *(const u32x4*)(K + (size_t)(jt * 64 + row) * DK + ch * 8);
    }
#pragma unroll
    for (int i = 0; i < 2; ++i) {
      const int id = tid + 256 * i, row = id >> 3, ch = id & 7;
      rv[i] = *(const u32x4*)(Vt + (size_t)row * Skv + jt * 64 + ch * 8);
    }
    if (MODE == 1) rf = F[jt * 64 + (tid & 63)];
  };
  auto swrite = [&](int buf) {
#pragma unroll
    for (int i = 0; i < NKL; ++i) {
      const int id = tid + 256 * i, row = id / KCH, ch = id % KCH;
      *(u32x4*)(sK + buf * 64 * LDK + row * LDK + ch * 8) = rk[i];
    }
#pragma unroll
    for (int i = 0; i < 2; ++i) {
      const int id = tid + 256 * i, row = id >> 3, ch = id & 7;
      *(u32x4*)(sV + buf * 64 * 72 + row * 72 + ch * 8) = rv[i];
    }
    if (MODE == 1) { if (tid < 64) sF[buf * 64 + tid] = Fref - rf; }
  };

  constexpr bool ASC = MODE != 2;
  int start = 0;
  if (MODE == 1) {
    float qq = 0.f;
#pragma unroll
    for (int ks = 0; ks < NKS; ++ks)
#pragma unroll
      for (int e = 0; e < 8; ++e) { const float v = __uint_as_float(((unsigned)(unsigned short)qf[ks][e]) << 16); qq += v * v; }
    qq += __shfl_xor(qq, 32);
#pragma unroll
    for (int o = 16; o >= 1; o >>= 1) qq = fmaxf(qq, __shfl_xor(qq, o));
    int* sStart = sFlag + 8;
    float* sQN = (float*)(sFlag + 12);
    if (lane == 0) sQN[wave] = qq;
    if (tid == 0) *sStart = ntiles - 2;
    __syncthreads();
    const float qn = sqrtf(fmaxf(fmaxf(sQN[0], sQN[1]), fmaxf(sQN[2], sQN[3]))) * 1.0001f;
    if (tid < ntiles - 2) {
      const float kd = fmaxf(KN[ntiles - 1], KN[ntiles - 2]);
      const float ex = qn * (KN[tid] + kd) + Fref - F[tid * 64 + 63];
      if (!(ex < -64.f)) atomicMin(sStart, tid);
    }
    __syncthreads();
    start = *sStart;
  }
  const int nit = ntiles - start;
  gload(ASC ? start : ntiles - 1);
  swrite(0);
  __syncthreads();
  for (int it = 0; it < nit; ++it) {
    const int jt = ASC ? start + it : ntiles - 1 - it;
    const int cur = it & 1;
    const bool more = it + 1 < nit;
    if (more) gload(ASC ? jt + 1 : jt - 1);
    const int key0 = jt * 64;
    const bool active = !CAUSAL || (key0 <= tq0 + 31);
    if (active) {
      f32x16 s0, s1;
      const bf16_t* kb = sK + cur * 64 * LDK + l32 * LDK + h * 8;
      bf16x8 kf0[NKS], kf1[NKS];
#pragma unroll
      for (int ks = 0; ks < NKS; ++ks) { kf0[ks] = *(const bf16x8*)(kb + ks * 16); kf1[ks] = *(const bf16x8*)(kb + 32 * LDK + ks * 16); }
      if (MODE == 1) {
        const float* fb = sF + cur * 64 + 4 * h;
#pragma unroll
        for (int g = 0; g < 4; ++g) {
          const f32x4 f0 = *(const f32x4*)(fb + 8 * g), f1 = *(const f32x4*)(fb + 32 + 8 * g);
          s0[4 * g] = f0.x; s0[4 * g + 1] = f0.y; s0[4 * g + 2] = f0.z; s0[4 * g + 3] = f0.w;
          s1[4 * g] = f1.x; s1[4 * g + 1] = f1.y; s1[4 * g + 2] = f1.z; s1[4 * g + 3] = f1.w;
        }
      } else {
#pragma unroll
        for (int e = 0; e < 16; ++e) { s0[e] = 0.f; s1[e] = 0.f; }
      }
      __builtin_amdgcn_iglp_opt(0);
      __builtin_amdgcn_s_setprio(1);
#pragma unroll
      for (int ks = 0; ks < NKS; ++ks) { s0 = MFMA(kf0[ks], qf[ks], s0); s1 = MFMA(kf1[ks], qf[ks], s1); }
      __builtin_amdgcn_s_setprio(0);
      const bf16_t* vb = sV + cur * 64 * 72 + l32 * 72 + h * 8;
      bf16x8 vf0[4], vf1[4];
#pragma unroll
      for (int j = 0; j < 4; ++j) { vf0[j] = *(const bf16x8*)(vb + j * 16); vf1[j] = *(const bf16x8*)(vb + 32 * 72 + j * 16); }
      __builtin_amdgcn_sched_barrier(0);
      const bool need_mask = CAUSAL && (key0 + 63 >= tq0);
      bf16x8 pf[4];
      if (MODE != 2) {
        if (need_mask) {
#pragma unroll
          for (int e = 0; e < 16; ++e) {
            const int key = key0 + 8 * (e >> 2) + 4 * h + (e & 3);
            if (key > qpos) s0[e] = -1e30f;
            if (key + 32 > qpos) s1[e] = -1e30f;
          }
        }
        float mx = s0[0];
#pragma unroll
        for (int e = 1; e < 16; ++e) mx = fmaxf(mx, s0[e]);
#pragma unroll
        for (int e = 0; e < 16; ++e) mx = fmaxf(mx, s1[e]);
        mx = fmaxf(mx, __shfl_xor(mx, 32));
        if (__any(mx > m + 8.f)) {
          const float mnew = fmaxf(m, mx);
          const float alpha = __builtin_amdgcn_exp2f(m - mnew);
          m = mnew; lsum *= alpha;
#pragma unroll
          for (int e = 0; e < 16; ++e) { o0[e] *= alpha; o1[e] *= alpha; }
        }
        float ps0 = 0.f, ps1 = 0.f, ps2 = 0.f, ps3 = 0.f;
#pragma unroll
        for (int e = 0; e < 16; ++e) s0[e] = __builtin_amdgcn_exp2f(s0[e] - m);
#pragma unroll
        for (int e = 0; e < 16; e += 4) { ps0 += s0[e]; ps1 += s0[e + 1]; ps2 += s0[e + 2]; ps3 += s0[e + 3]; }
#pragma unroll
        for (int e = 0; e < 16; ++e) s1[e] = __builtin_amdgcn_exp2f(s1[e] - m);
#pragma unroll
        for (int e = 0; e < 16; e += 4) { ps0 += s1[e]; ps1 += s1[e + 1]; ps2 += s1[e + 2]; ps3 += s1[e + 3]; }
        lsum += (ps0 + ps1) + (ps2 + ps3);
      } else {
        f32x16 kp0, kp1;
#pragma unroll
        for (int e = 0; e < 16; ++e) {
          const float e0 = __builtin_amdgcn_exp2f(fminf(s0[e], 80.f)), e1 = __builtin_amdgcn_exp2f(fminf(s1[e], 80.f));
          kp0[e] = __builtin_amdgcn_rcpf(1.f + e0); kp1[e] = __builtin_amdgcn_rcpf(1.f + e1);
          s0[e] = e0 * kp0[e]; s1[e] = e1 * kp1[e];
        }
        if (need_mask) {
#pragma unroll
          for (int e = 0; e < 16; ++e) {
            const int key = key0 + 8 * (e >> 2) + 4 * h + (e & 3);
            if (key >= qpos) { kp0[e] = 1.f; s0[e] = 0.f; }
            if (key + 32 >= qpos) { kp1[e] = 1.f; s1[e] = 0.f; }
          }
        }
#pragma unroll
        for (int kt = 1; kt >= 0; --kt) {
          f32x16& kp = kt ? kp1 : kp0;
          f32x16& w = kt ? s1 : s0;
          float sfx[4][4];
#pragma unroll
          for (int g = 0; g < 4; ++g) {
            sfx[g][3] = kp[4 * g + 3];
            sfx[g][2] = kp[4 * g + 2] * sfx[g][3];
            sfx[g][1] = kp[4 * g + 1] * sfx[g][2];
            sfx[g][0] = kp[4 * g] * sfx[g][1];
          }
          float Gp[4], Dg[4];
#pragma unroll
          for (int g = 0; g < 4; ++g) { Gp[g] = __shfl_xor(sfx[g][0], 32); Dg[g] = sfx[g][0] * Gp[g]; }
          float E[4];
          E[3] = 1.f; E[2] = Dg[3]; E[1] = Dg[3] * Dg[2]; E[0] = E[1] * Dg[1];
          const float tot = E[0] * Dg[0];
#pragma unroll
          for (int g = 0; g < 4; ++g) {
            const float base = R * E[g] * (h == 0 ? Gp[g] : 1.f);
            w[4 * g + 3] *= base;
            w[4 * g + 2] *= base * sfx[g][3];
            w[4 * g + 1] *= base * sfx[g][2];
            w[4 * g] *= base * sfx[g][1];
          }
          R *= tot;
        }
      }
#pragma unroll
      for (int j = 0; j < 2; ++j) {
        u32x4 a, b;
        a.x = pack2(s0[8 * j], s0[8 * j + 1]); a.y = pack2(s0[8 * j + 2], s0[8 * j + 3]); a.z = pack2(s0[8 * j + 4], s0[8 * j + 5]); a.w = pack2(s0[8 * j + 6], s0[8 * j + 7]);
        b.x = pack2(s1[8 * j], s1[8 * j + 1]); b.y = pack2(s1[8 * j + 2], s1[8 * j + 3]); b.z = pack2(s1[8 * j + 4], s1[8 * j + 5]); b.w = pack2(s1[8 * j + 6], s1[8 * j + 7]);
        pf[j] = __builtin_bit_cast(bf16x8, a); pf[2 + j] = __builtin_bit_cast(bf16x8, b);
      }
      __builtin_amdgcn_s_setprio(1);
#pragma unroll
      for (int j = 0; j < 4; ++j) { o0 = MFMA(vf0[j], pf[j], o0); o1 = MFMA(vf1[j], pf[j], o1); }
      __builtin_amdgcn_s_setprio(0);
    }
    __builtin_amdgcn_sched_barrier(0);
    if (more) swrite(cur ^ 1);
    if (MODE == 2) { const int done = __all(R == 0.f); if (lane == 0) sFlag[cur * 4 + wave] = done; }
    __syncthreads();
    if (MODE == 2) { if (sFlag[cur * 4] & sFlag[cur * 4 + 1] & sFlag[cur * 4 + 2] & sFlag[cur * 4 + 3]) break; }
  }
  float inv = 1.f;
  if (MODE != 2) { const float lt = lsum + __shfl_xor(lsum, 32); inv = 1.f / lt; }
  const bf16_t* gp = gate + (size_t)qpos * 1024;
  bf16_t* op = outp + (size_t)qpos * 1024;
#pragma unroll
  for (int dt = 0; dt < 2; ++dt)
#pragma unroll
    for (int g = 0; g < 4; ++g) {
      const int dv = 32 * dt + 8 * g + 4 * h;
      const u32x2 gv = *(const u32x2*)(gp + dv);
      const f32x16& o = dt ? o1 : o0;
      const float g0 = __uint_as_float(gv.x << 16), g1 = __uint_as_float(gv.x & 0xffff0000u), g2 = __uint_as_float(gv.y << 16), g3 = __uint_as_float(gv.y & 0xffff0000u);
      *(u32x2*)(op + dv) = pack4(o[4 * g] * inv * g0, o[4 * g + 1] * inv * g1, o[4 * g + 2] * inv * g2, o[4 * g + 3] * inv * g3);
    }
  __syncthreads();
}

DI void phase3(PP p, int l, int cofs, char* smem) {
  const int xcd = blockIdx.x & 7, slot = blockIdx.x >> 3, nslots = gridDim.x >> 3;
  for (int pj = slot; pj < 128; pj += nslots) {
    const int k = pj >> 5, i = pj & 31;
    const int type = (k == 1 || k == 2) ? 1 : 0, bh = xcd * 2 + (k >> 1), b = bh >> 2, hd = bh & 3;
    const size_t tokbase = (size_t)b * S_ * 1024;
    for (int half = 0; half < 2; ++half) {
      const int qb = half ? 63 - i : i;
      if (type == 0) {
        const size_t off = (size_t)bh * S_ * 64;
        attn_job<64, 1>(p->Qf + off, p->Kf + off, p->Vtf + off, p->Fc + (size_t)bh * S_, p->knorm + bh * 128, S_, qb, 2 * (qb + 1),
                        p->gs + tokbase + hd * 64, p->mixedg + tokbase + hd * 64, smem);
      } else {
        attn_job<96, 0>(p->Qm + (size_t)bh * S_ * 96, p->Km + (size_t)bh * S_ * 96, p->Vtm + (size_t)bh * S_ * 64, nullptr, nullptr, S_, qb, 2 * (qb + 1),
                        p->gs + tokbase + 512 + hd * 64, p->mixedg + tokbase + 512 + hd * 64, smem);
      }
    }
  }
  for (int j = slot; j < 128; j += nslots) {
    const int bh = xcd * 2 + (j >> 6), qb = j & 63, b = bh >> 2, hd = bh & 3;
    const size_t tokbase = (size_t)b * S_ * 1024, off = (size_t)bh * S_ * 64;
    attn_job<64, 2>(p->Qs + off, p->Ks + off, p->Vts + off, nullptr, nullptr, S_, qb, 2 * (qb + 1),
                    p->gs + tokbase + 256 + hd * 64, p->mixedg + tokbase + 256 + hd * 64, smem);
    const size_t moff = ((size_t)l * 16 + bh) * 256 * 64;
    attn_job<64, 3>(p->Qx + off, p->Kx + moff, p->Vtx + moff, nullptr, nullptr, MEM_, qb, 4,
                    p->gs + tokbase + 768 + hd * 64, p->mixedg + tokbase + 768 + hd * 64, smem);
  }
}


#define XB_TMO      128
#define XB_XCNT(j)  (256  + 64 * (j))
#define XB_XSUB(j)  (1280 + 64 * (j))
#define XB_XGEN(j)  (2304 + 64 * (j))
#define XB_TOP      3328
#define XB_TOPGEN   3392
#define XB_SPIN_CAP (1u << 18)
DI unsigned xb_ld(unsigned* p)              { return __hip_atomic_load(p, __ATOMIC_RELAXED, __HIP_MEMORY_SCOPE_AGENT); }
DI unsigned xb_add(unsigned* p, unsigned v) { return __hip_atomic_fetch_add(p, v, __ATOMIC_RELAXED, __HIP_MEMORY_SCOPE_AGENT); }
DI unsigned xb_xcc_id() { return (unsigned)__builtin_amdgcn_s_getreg((3 << 11) | 20) & 0xFu; }
#define XB_SPIN(cond, bar) do { unsigned _sp = 0; while (cond) { __builtin_amdgcn_s_sleep(1); \
    if ((++_sp & 255u) == 0u) { if (xb_ld(&(bar)[XB_TMO])) break; if (_sp > XB_SPIN_CAP) { atomicAdd(&(bar)[XB_TMO], 1u); break; } } } } while (0)
struct XcdBarrier { unsigned* bar; unsigned x; volatile unsigned* st; };
DI XcdBarrier xcd_barrier_post(unsigned* bar, volatile unsigned* st) {
  XcdBarrier b; b.bar = bar; b.x = xb_xcc_id(); b.st = st;
  if (threadIdx.x == 0) (void)xb_add(&bar[XB_XCNT(b.x)], 1u);
  return b;
}
DI void xcd_barrier_complete(unsigned* bar, unsigned x, unsigned& nloc, unsigned& nx) {
  const unsigned G = gridDim.x * gridDim.y * gridDim.z;
  unsigned sum, cnt, mine, sp = 0u;
  for (;;) {
    sum = 0u; cnt = 0u; mine = 0u;
#pragma unroll
    for (unsigned j = 0; j < 16; ++j) { const unsigned c = xb_ld(&bar[XB_XCNT(j)]); sum += c; cnt += (c > 0u) ? 1u : 0u; mine = (j == x) ? c : mine; }
    if (sum == G) break;
    __builtin_amdgcn_s_sleep(1);
    if ((++sp & 255u) == 0u) { if (xb_ld(&bar[XB_TMO])) break; if (sp > XB_SPIN_CAP) { atomicAdd(&bar[XB_TMO], 1u); break; } }
  }
  nloc = mine > 0u ? mine : 1u; nx = cnt > 0u ? cnt : 1u;
}
DI void xcd_barrier(const XcdBarrier& b) {
  asm volatile("s_waitcnt vmcnt(0)" ::: "memory");
  __syncthreads();
  if (threadIdx.x == 0) {
    unsigned* bar = b.bar;
    __builtin_amdgcn_s_waitcnt(0);
    unsigned nloc = b.st[0], nx = b.st[1];
    if (nloc == 0u) { xcd_barrier_complete(bar, b.x, nloc, nx); b.st[0] = nloc; b.st[1] = nx; }
    const unsigned old = xb_add(&bar[XB_XSUB(b.x)], 1u);
    const unsigned gen = old / nloc;
    if (old + 1u == (gen + 1u) * nloc) {
      __builtin_amdgcn_fence(__ATOMIC_RELEASE, "agent");
      asm volatile("s_waitcnt vmcnt(0)" ::: "memory");
      const unsigned og = xb_add(&bar[XB_TOP], 1u);
      const unsigned tg = og / nx;
      if (og + 1u == (tg + 1u) * nx) xb_add(&bar[XB_TOPGEN], 1u);
      else XB_SPIN(xb_ld(&bar[XB_TOPGEN]) == tg, bar);
      __builtin_amdgcn_fence(__ATOMIC_ACQUIRE, "agent");
      xb_add(&bar[XB_XGEN(b.x)], 1u);
      asm volatile("s_waitcnt vmcnt(0)" ::: "memory");
    } else {
      XB_SPIN(xb_ld(&bar[XB_XGEN(b.x)]) == gen, bar);
      __builtin_amdgcn_fence(__ATOMIC_ACQUIRE, "agent");
      asm volatile("s_waitcnt vmcnt(0)" ::: "memory");
    }
  }
  __syncthreads();
}

__global__ void __launch_bounds__(256, 2) mega(Params p_unused) {
  __shared__ __attribute__((aligned(16))) char smem[SMEM_BYTES];
  PP p = (PP)__builtin_amdgcn_kernarg_segment_ptr();
  volatile unsigned* xst = (volatile unsigned*)(smem + SMEM_GEMM + 768);
  if (threadIdx.x == 0) { xst[0] = 0u; xst[1] = 0u; }
  __syncthreads();
  XcdBarrier xb = xcd_barrier_post(launder(p)->xbar, xst);
  if (launder(p)->x == nullptr) cg::this_grid().sync();
  phase0(launder(p), smem);
  xcd_barrier(xb);
  for (int l = 0; l < 2; ++l) {
    phase1(launder(p), l, smem); xcd_barrier(xb);
    phase2(launder(p), l, smem); xcd_barrier(xb);
    phase3(launder(p), l, 0, smem); xcd_barrier(xb);
    phase4(launder(p), l, smem); xcd_barrier(xb);
    phase5(launder(p), l, smem);
    if (l == 0) xcd_barrier(xb);
  }
}

extern "C" void kernel_launch(void* const* d_in, const int* in_sizes, int n_in, void* d_out, int out_size, void* d_ws, size_t ws_size, hipStream_t stream) {
  static int grid_blocks = 0;
  if (!grid_blocks) {
    int dev = 0, cus = 0, per_cu = 0;
    hipGetDevice(&dev);
    hipDeviceGetAttribute(&cus, hipDeviceAttributeMultiprocessorCount, dev);
    hipOccupancyMaxActiveBlocksPerMultiprocessor(&per_cu, mega, 256, 0);
    if (per_cu > 2) per_cu = 2;
    if (per_cu < 1) per_cu = 1;
    grid_blocks = cus * per_cu;
  }
  Params p{};
  p.x = (const float*)d_in[0]; p.mem = (const float*)d_in[1]; p.ln_in_g = (const float*)d_in[2]; p.ln_in_b = (const float*)d_in[3];
  p.mem_ln_g = (const float*)d_in[4]; p.mem_ln_b = (const float*)d_in[5]; p.w_in = (const float*)d_in[6]; p.b_forget = (const float*)d_in[7];
  p.q_norm_g = (const float*)d_in[8]; p.w_q_up = (const float*)d_in[9]; p.kv_norm_g = (const float*)d_in[10]; p.w_kv_up = (const float*)d_in[11];
  p.w_mem_kv = (const float*)d_in[12]; p.w_out = (const float*)d_in[13]; p.ln_g = (const float*)d_in[14]; p.ln_b = (const float*)d_in[15];
  p.hres = (float*)d_out;
  char* w = (char*)d_ws;
  size_t off = 0;
  auto take = [&](size_t bytes) { char* r = w + off; off += (bytes + 255) & ~(size_t)255; return r; };
  const size_t TB = (size_t)T_;
  p.hb = (bf16_t*)take(TB * 1024 * 2); p.mixedg = (bf16_t*)take(TB * 1024 * 2); p.gs = (bf16_t*)take(TB * 1024 * 2);
  p.memn = (bf16_t*)take((size_t)1024 * 1024 * 2);
  p.WinT = (bf16_t*)take((size_t)2 * NP_ * 1024 * 2); p.WmemT = (bf16_t*)take((size_t)2 * 512 * 1024 * 2);
  p.WqupT = (bf16_t*)take((size_t)2 * 384 * 256 * 2); p.WkvupT = (bf16_t*)take((size_t)2 * 512 * 128 * 2); p.WoutT = (bf16_t*)take((size_t)2 * 1024 * 1024 * 2);
  p.Qf = (bf16_t*)take(TB * 256 * 2); p.Kf = (bf16_t*)take(TB * 256 * 2); p.Vtf = (bf16_t*)take(TB * 256 * 2);
  p.Qs = (bf16_t*)take(TB * 256 * 2); p.Ks = (bf16_t*)take(TB * 256 * 2); p.Vts = (bf16_t*)take(TB * 256 * 2);
  p.Qm = (bf16_t*)take(TB * 384 * 2); p.Km = (bf16_t*)take(TB * 384 * 2); p.Vtm = (bf16_t*)take(TB * 256 * 2);
  p.Qx = (bf16_t*)take(TB * 256 * 2); p.Kx = (bf16_t*)take((size_t)2 * 16 * 256 * 64 * 2); p.Vtx = (bf16_t*)take((size_t)2 * 16 * 256 * 64 * 2);
  p.cq = (bf16_t*)take(TB * 256 * 2); p.ckv = (bf16_t*)take(TB * 128 * 2); p.krope = (bf16_t*)take(TB * 32 * 2);
  p.logf = (float*)take((size_t)16 * S_ * 4); p.Fc = (float*)take((size_t)16 * S_ * 4); p.knorm = (float*)take((size_t)16 * 128 * 4);
  p.ropetab = (float2*)take((size_t)S_ * 16 * 8);
  p.counters = (unsigned*)take(256);
  p.xbar = (unsigned*)take((size_t)XCD_BAR_WORDS * 4);
  p.stat0 = (float2*)take((size_t)T_ * 8); p.stat1 = (float2*)take((size_t)T_ * 8);
  if (off > ws_size) { fprintf(stderr, "workspace too small: need %zu have %zu\n", off, ws_size); return; }
  hipMemsetAsync(p.xbar, 0, (size_t)XCD_BAR_WORDS * 4, stream);
  void* args[] = {&p};
  hipError_t e = hipLaunchCooperativeKernel((void*)mega, dim3(grid_blocks), dim3(256), args, 0, stream);
  if (e != hipSuccess) fprintf(stderr, "cooperative launch failed: %s (grid %d)\n", hipGetErrorString(e), grid_blocks);
}
```
